# Optimizing an MI355X kernel written in HIP

```python
import math
import jax, jax.numpy as jnp
from jax import lax
import numpy as np

D_MODEL = 1024
BATCH = 32
SEQ = 2048
DEPTH = 2
DEC_BATCH = 32
DEC_SEQ = 16
PAST_LEN = 1024

CHUNK = 64
Q_BLOCK = 128
N_A_LAYERS = DEPTH // 2
N_B_LAYERS = DEPTH - N_A_LAYERS
GLA_HEADS = 4
GLA_DK = D_MODEL // 2
GLA_DV = D_MODEL
GLA_DKH = GLA_DK // GLA_HEADS
GLA_DVH = GLA_DV // GLA_HEADS
GATE_RANK = 16
GATE_TAU = 16.0
A_IN = 2 * GLA_DK + 2 * GLA_DV + GATE_RANK
DIFF_HEADS = 8
DIFF_HD = D_MODEL // (2 * DIFF_HEADS)
DIFF_QK = DIFF_HEADS * 2 * DIFF_HD
DIFF_V = DIFF_HEADS * 2 * DIFF_HD
ROPE_DIMS = DIFF_HD // 4
ROPE_THETA = 500000.0
D_FF = 4 * D_MODEL
DEEPNORM_ALPHA = (2 * DEPTH) ** 0.25
DEEPNORM_BETA = (8 * DEPTH) ** -0.25
LN_EPS = 1e-5
RMS_EPS = 1e-5

kernel_name = 'yoco_gla_diffattn_stream_step'


def layer_norm(x, g, b):
    xf = x.astype(jnp.float32)
    mu = jnp.mean(xf, -1, keepdims=True)
    var = jnp.mean(jnp.square(xf - mu), -1, keepdims=True)
    return ((xf - mu) * lax.rsqrt(var + LN_EPS) * g + b).astype(x.dtype)


def rms_norm(x, g):
    xf = x.astype(jnp.float32)
    return (xf * lax.rsqrt(jnp.mean(xf * xf, -1, keepdims=True) + RMS_EPS) * g).astype(x.dtype)


def partial_rope(x, pos):
    inv = 1.0 / (ROPE_THETA ** (jnp.arange(0, ROPE_DIMS, 2, dtype=jnp.float32) / ROPE_DIMS))
    ang = pos.astype(jnp.float32)[:, None] * inv[None, :]
    cos = jnp.cos(ang)[:, None, None, :]
    sin = jnp.sin(ang)[:, None, None, :]
    xr = x[..., :ROPE_DIMS].astype(jnp.float32)
    x1, x2 = xr[..., :ROPE_DIMS // 2], xr[..., ROPE_DIMS // 2:]
    rot = jnp.concatenate([x1 * cos - x2 * sin, x2 * cos + x1 * sin], -1)
    return jnp.concatenate([rot.astype(x.dtype), x[..., ROPE_DIMS:]], -1)


def gla_project(x, w_in, w_gate_up, b_gate):
    B, T, _ = x.shape
    h = x @ w_in
    q, k, v, r, gl = jnp.split(h, [GLA_DK, 2 * GLA_DK, 2 * GLA_DK + GLA_DV, 2 * GLA_DK + 2 * GLA_DV], axis=-1)
    logit = (gl @ w_gate_up + b_gate).astype(jnp.float32)
    log_a = (jax.nn.log_sigmoid(logit) / GATE_TAU).reshape(B, T, GLA_HEADS, GLA_DKH)
    q = q.reshape(B, T, GLA_HEADS, GLA_DKH) * (GLA_DKH ** -0.5)
    k = k.reshape(B, T, GLA_HEADS, GLA_DKH)
    v = v.reshape(B, T, GLA_HEADS, GLA_DVH)
    return q, k, v, log_a, r


def gla_block(S, q, k, v, log_a):
    C = q.shape[1]
    b = jnp.cumsum(log_a, axis=1)
    qf = q.astype(jnp.float32) * jnp.exp(b)
    kf = k.astype(jnp.float32) * jnp.exp(-b)
    vf = v.astype(jnp.float32)
    inter = jnp.einsum('bchk,bhkv->bchv', qf, S)
    att = jnp.einsum('bihk,bjhk->bhij', qf, kf)
    att = jnp.where(jnp.tril(jnp.ones((C, C), dtype=bool)), att, 0.0)
    intra = jnp.einsum('bhij,bjhv->bihv', att, vf)
    b_last = b[:, -1]
    k_tail = k.astype(jnp.float32) * jnp.exp(b_last[:, None] - b)
    S_new = S * jnp.exp(b_last)[..., None] + jnp.einsum('bjhk,bjhv->bhkv', k_tail, vf)
    return S_new, inter + intra


def gla_prompt(q, k, v, log_a):
    B, T = q.shape[:2]
    n = T // CHUNK

    def to_blocks(a):
        return a.reshape(B, n, CHUNK, *a.shape[2:]).swapaxes(0, 1)

    S0 = jnp.zeros((B, GLA_HEADS, GLA_DKH, GLA_DVH), jnp.float32)

    def step(S, inp):
        return gla_block(S, *inp)

    S_fin, o = lax.scan(step, S0, (to_blocks(q), to_blocks(k), to_blocks(v), to_blocks(log_a)))
    return o.swapaxes(0, 1).reshape(B, T, GLA_HEADS, GLA_DVH), S_fin


def gla_output(o, r, g_norm, w_o):
    B, T = o.shape[:2]
    o = rms_norm(o, g_norm).reshape(B, T, GLA_DV).astype(r.dtype)
    return (o * jax.nn.silu(r)) @ w_o


def shared_kv(h, w_kv, pos):
    B, T, _ = h.shape
    kv = h @ w_kv
    k, v = jnp.split(kv, [DIFF_QK], axis=-1)
    k = partial_rope(k.reshape(B, T, DIFF_HEADS, 2, DIFF_HD), pos)
    v = v.reshape(B, T, DIFF_HEADS, 2 * DIFF_HD)
    return k, v


def diff_query(x, w_q, pos):
    B, T, _ = x.shape
    q = (x @ w_q).reshape(B, T, DIFF_HEADS, 2, DIFF_HD)
    return partial_rope(q, pos) * (DIFF_HD ** -0.5)


def diff_lambda(lam, lambda_init):
    lam = lam.astype(jnp.float32)
    return jnp.exp(jnp.sum(lam[0] * lam[1])) - jnp.exp(jnp.sum(lam[2] * lam[3])) + lambda_init


def diff_attn_prompt(q, k, v, lam):
    T = q.shape[1]
    chunk_id = jnp.arange(T) // CHUNK
    outs = []
    for i in range(T // Q_BLOCK):
        qs, qe = i * Q_BLOCK, (i + 1) * Q_BLOCK
        s = jnp.einsum('bqhcd,bkhcd->bhcqk', q[:, qs:qe], k[:, :qe]).astype(jnp.float32)
        mask = chunk_id[None, :qe] <= chunk_id[qs:qe, None]
        p = jax.nn.softmax(jnp.where(mask, s, -jnp.inf), axis=-1)
        a = (p[:, :, 0] - lam * p[:, :, 1]).astype(v.dtype)
        outs.append(jnp.einsum('bhqk,bkhv->bqhv', a, v[:, :qe]))
    return jnp.concatenate(outs, axis=1)


def diff_attn_sample(q, k_new, v_new, cache_k, cache_v, lam):
    P = cache_k.shape[1]
    s_past = jnp.einsum('bqhcd,bkhcd->bhcqk', q, cache_k)
    s_new = jnp.einsum('bqhcd,bkhcd->bhcqk', q, k_new)
    s = jnp.concatenate([s_past, s_new], axis=-1).astype(jnp.float32)
    p = jax.nn.softmax(s, axis=-1)
    a = (p[:, :, 0] - lam * p[:, :, 1]).astype(v_new.dtype)
    return (jnp.einsum('bhqk,bkhv->bqhv', a[..., :P], cache_v)
            + jnp.einsum('bhqk,bkhv->bqhv', a[..., P:], v_new))


def diff_output(o, g_norm, lambda_init, w_o):
    B, T = o.shape[:2]
    o = rms_norm(o, g_norm) * (1.0 - lambda_init)
    return o.reshape(B, T, DIFF_V) @ w_o


def sqrelu_mlp(x, w_up, w_down):
    return jnp.square(jax.nn.relu(x @ w_up)) @ w_down


def run_trunk(x, pos, state_gla, cache_k, cache_v, w_in_a, w_gate_up_a, b_gate_a, g_norm_a, w_o_a,
              w_kv, w_q_b, lam_b, g_norm_b, w_o_b, w_up, w_down, ln_g, ln_b):
    gla_states = []
    k_sh = v_sh = None
    for layer in range(DEPTH):
        if layer < N_A_LAYERS:
            i = layer
            q, k, v, log_a, r = gla_project(x, w_in_a[i], w_gate_up_a[i], b_gate_a[i])
            if state_gla is None:
                o, s_fin = gla_prompt(q, k, v, log_a)
            else:
                s_fin, o = gla_block(state_gla[i].astype(jnp.float32), q, k, v, log_a)
            gla_states.append(s_fin.astype(x.dtype))
            mix = gla_output(o, r, g_norm_a[i], w_o_a[i])
        else:
            j = layer - N_A_LAYERS
            lambda_init = 0.8 - 0.6 * math.exp(-0.3 * layer)
            lam = diff_lambda(lam_b[j], lambda_init)
            q = diff_query(x, w_q_b[j], pos)
            if cache_k is None:
                o = diff_attn_prompt(q, k_sh, v_sh, lam)
            else:
                o = diff_attn_sample(q, k_sh, v_sh, cache_k, cache_v, lam)
            mix = diff_output(o, g_norm_b[j], lambda_init, w_o_b[j])
        x = layer_norm(DEEPNORM_ALPHA * x + mix.astype(x.dtype), ln_g[layer, 0], ln_b[layer, 0])
        x = layer_norm(DEEPNORM_ALPHA * x + sqrelu_mlp(x, w_up[layer], w_down[layer]).astype(x.dtype),
                       ln_g[layer, 1], ln_b[layer, 1])
        if layer == N_A_LAYERS - 1:
            k_sh, v_sh = shared_kv(x, w_kv, pos)
    return x, jnp.stack(gla_states), k_sh, v_sh


def setup_inputs(seed: int = 0) -> dict:
    key = jax.random.key(seed)
    ks = jax.random.split(key, 19)

    def nrm(k, shape, scale):
        return jax.random.normal(k, shape, jnp.float32) * scale

    return {
        'x_prompt': nrm(ks[0], (BATCH, SEQ, D_MODEL), 1.0),
        'x_sample': nrm(ks[1], (DEC_BATCH, DEC_SEQ, D_MODEL), 1.0),
        'state_gla': nrm(ks[2], (N_A_LAYERS, DEC_BATCH, GLA_HEADS, GLA_DKH, GLA_DVH), 0.5),
        'cache_k': nrm(ks[3], (DEC_BATCH, PAST_LEN, DIFF_HEADS, 2, DIFF_HD), 1.0),
        'cache_v': nrm(ks[4], (DEC_BATCH, PAST_LEN, DIFF_HEADS, 2 * DIFF_HD), 1.0),
        'w_in_a': nrm(ks[5], (N_A_LAYERS, D_MODEL, A_IN), D_MODEL ** -0.5),
        'w_gate_up_a': nrm(ks[6], (N_A_LAYERS, GATE_RANK, GLA_DK), GATE_RANK ** -0.5),
        'b_gate_a': nrm(ks[7], (N_A_LAYERS, GLA_DK), 0.1),
        'g_norm_a': 1.0 + nrm(ks[8], (N_A_LAYERS, GLA_DVH), 0.01),
        'w_o_a': nrm(ks[9], (N_A_LAYERS, GLA_DV, D_MODEL), GLA_DV ** -0.5 * DEEPNORM_BETA),
        'w_kv': nrm(ks[10], (D_MODEL, DIFF_QK + DIFF_V), D_MODEL ** -0.5),
        'w_q_b': nrm(ks[11], (N_B_LAYERS, D_MODEL, DIFF_QK), D_MODEL ** -0.5),
        'lam_b': nrm(ks[12], (N_B_LAYERS, 4, DIFF_HD), 0.1),
        'g_norm_b': 1.0 + nrm(ks[13], (N_B_LAYERS, 2 * DIFF_HD), 0.01),
        'w_o_b': nrm(ks[14], (N_B_LAYERS, DIFF_V, D_MODEL), DIFF_V ** -0.5 * DEEPNORM_BETA),
        'w_up': nrm(ks[15], (DEPTH, D_MODEL, D_FF), D_MODEL ** -0.5),
        'w_down': nrm(ks[16], (DEPTH, D_FF, D_MODEL), D_FF ** -0.5 * DEEPNORM_BETA),
        'ln_g': 1.0 + nrm(ks[17], (DEPTH, 2, D_MODEL), 0.01),
        'ln_b': nrm(ks[18], (DEPTH, 2, D_MODEL), 0.01),
    }


def reference(x_prompt, x_sample, state_gla, cache_k, cache_v, w_in_a, w_gate_up_a, b_gate_a, g_norm_a,
              w_o_a, w_kv, w_q_b, lam_b, g_norm_b, w_o_b, w_up, w_down, ln_g, ln_b):
    pos_prompt = jnp.arange(x_prompt.shape[1])
    pos_sample = cache_k.shape[1] + jnp.arange(x_sample.shape[1])
    y_prompt, gla_prompt_state, k_prompt, v_prompt = run_trunk(
        x_prompt, pos_prompt, None, None, None, w_in_a, w_gate_up_a, b_gate_a, g_norm_a, w_o_a,
        w_kv, w_q_b, lam_b, g_norm_b, w_o_b, w_up, w_down, ln_g, ln_b)
    y_sample, gla_sample_state, k_sample, v_sample = run_trunk(
        x_sample, pos_sample, state_gla, cache_k, cache_v, w_in_a, w_gate_up_a, b_gate_a, g_norm_a, w_o_a,
        w_kv, w_q_b, lam_b, g_norm_b, w_o_b, w_up, w_down, ln_g, ln_b)
    return (y_prompt, y_sample, gla_prompt_state, k_prompt, v_prompt, gla_sample_state, k_sample, v_sample)
```

```cpp
#include <hip/hip_runtime.h>
#include <hip/hip_cooperative_groups.h>
#include <cstdio>
#include <cstdint>
#include <cmath>
namespace cg = cooperative_groups;
namespace pg8 {
#define PG8_LAS __attribute__((address_space(3)))
typedef unsigned short bf16_t;
typedef short bf16x8 __attribute__((ext_vector_type(8)));
typedef float f32x4 __attribute__((ext_vector_type(4)));
typedef unsigned u32x4 __attribute__((ext_vector_type(4)));
constexpr int BM = 256, BK = 64, HALF = 128, HTB = HALF * BK * 2  , STAGE_BYTES = 8 * HTB, NXCD = 8, WGM = 8;

__host__ __device__ __forceinline__ int lds_byte(int r, int c) { const int st = (r >> 4) * 2 + (c >> 5), rr = r & 15, cc = c & 31, ob = rr * 64 + cc * 2; return st * 1024 + (ob ^ (((ob >> 9) & 1) << 5)); }
__host__ __device__ __forceinline__ void stage_rc(int b, int& R, int& C) { const int st = b / 1024, sb = b % 1024, swz = sb ^ (((sb >> 9) & 1) << 5); R = (st >> 1) * 16 + swz / 64; C = (st & 1) * 32 + (swz % 64) / 2; }
__host__ __device__ __forceinline__ int perm32(int rho) { const int n = rho >> 4, i = rho & 15; return 8 * (i >> 2) + 4 * n + (i & 3); }

struct Unit { int pm, pn; };
struct Gemm { const bf16_t* A; const bf16_t* Bt; int M, N, K; };

struct StaticOrder {
    int nM, nN, nwg, G, c;
    __host__ __device__ void init(int M, int N, int G_, int c_) { nM = M / BM; nN = N / BM; nwg = nM * nN; G = G_; c = c_; }
    __host__ __device__ bool next(int i, Unit& u) const {
        const long L = (long)i * G + c; if (L >= nwg) return false;
        int wgid = (int)L; { const int q = nwg / NXCD, r = nwg % NXCD, xcd = wgid % NXCD, off = wgid / NXCD; wgid = (xcd < r ? xcd * (q + 1) : r * (q + 1) + (xcd - r) * q) + off; }
        const int nig = WGM * nN, gid = wgid / nig, fm = gid * WGM, gsz = (nM - fm) < WGM ? (nM - fm) : WGM;
        u.pm = fm + ((wgid % nig) % gsz); u.pn = (wgid % nig) / gsz; return true;
    }
    __device__ __forceinline__ void a_ready(const Unit&) const {}
    __device__ __forceinline__ void done(const Unit&) const {}
};

typedef float f32x2 __attribute__((ext_vector_type(2)));
template <class Epi, class Sched, bool ALIGN_EPI = false, bool SP2 = false>
__device__ __forceinline__ void gemm_phase(PG8_LAS unsigned char* lds, const Gemm g, const Sched& S, const Epi& E) {
    const int tid = threadIdx.x, wid = __builtin_amdgcn_readfirstlane(tid >> 6), lane = tid & 63, wr = wid >> 2, wc = wid & 3, fr = lane & 15, fq = lane >> 4;
    const int K = g.K, nt = K / BK;
    unsigned voffA[2], voffB[2];
#pragma unroll
    for (int i = 0; i < 2; ++i) { int R, C; stage_rc(tid * 16 + i * 8192, R, C); const int Rb = Epi::PERM ? ((R & ~31) + perm32(R & 31)) : R;
        voffA[i] = (unsigned)(R * K + C) * 2u; voffB[i] = (unsigned)(Rb * K + C) * 2u; }
    const size_t kstep = (size_t)(BK * 2);
    const size_t hstep = (size_t)HALF * K * 2;
    const size_t tstep = 2 * hstep;
    const unsigned ldsw = (unsigned)wid * 1024u;
    const int aoff = lds_byte(wr * 64 + fr, fq * 8), boff = lds_byte(wc * 32 + fr, fq * 8);
#define PG8_SA(b, h) (((b) * 2 + (h)) * HTB)
#define PG8_SB(b, h) ((4 + (b) * 2 + (h)) * HTB)
#define PG8_STAGE(bufoff, gbase, voff) do { _Pragma("unroll") for (int _i = 0; _i < 2; ++_i) \
        __builtin_amdgcn_global_load_lds((const unsigned*)((const char*)(gbase) + (voff)[_i]), (PG8_LAS unsigned*)(lds + (bufoff) + ldsw + _i * 8192), 16, 0, 0); } while (0)
#define PG8_LDA(dst, b, h) do { _Pragma("unroll") for (int m = 0; m < 4; ++m) _Pragma("unroll") for (int k = 0; k < 2; ++k) dst[m][k] = *(const PG8_LAS bf16x8*)(lds + PG8_SA(b, h) + aoff + m * 2048 + k * 1024); } while (0)
#define PG8_LDB(dst, b, h) do { _Pragma("unroll") for (int n = 0; n < 2; ++n) _Pragma("unroll") for (int k = 0; k < 2; ++k) dst[n][k] = *(const PG8_LAS bf16x8*)(lds + PG8_SB(b, h) + boff + n * 2048 + k * 1024); } while (0)
#define PG8_MMA(ai, bj, At, Bt) do { __builtin_amdgcn_s_setprio(1); _Pragma("unroll") for (int m = 0; m < 4; ++m) _Pragma("unroll") for (int n = 0; n < 2; ++n) _Pragma("unroll") for (int k = 0; k < 2; ++k) \
        acc[ai][bj][m][n] = __builtin_amdgcn_mfma_f32_16x16x32_bf16(Bt[n][k], At[m][k], acc[ai][bj][m][n], 0, 0, 0); __builtin_amdgcn_s_setprio(0); } while (0)
#define PG8_WAIT_V(n) asm volatile("s_waitcnt vmcnt(" #n ")" ::: "memory")
#define PG8_WAIT_L(n) asm volatile("s_waitcnt lgkmcnt(" #n ")" ::: "memory")
#define PG8_BAR __builtin_amdgcn_s_barrier()
#define PG8_SCHED __builtin_amdgcn_sched_barrier(0)
    Unit cur, nxt; int ui = 0;
    if (!S.next(0, cur)) return;
    f32x4 acc[2][2][4][2];
#pragma unroll
    for (int a = 0; a < 2; ++a)
#pragma unroll
        for (int b = 0; b < 2; ++b)
#pragma unroll
            for (int m = 0; m < 4; ++m)
#pragma unroll
                for (int n = 0; n < 2; ++n) acc[a][b][m][n] = (f32x4){0.f, 0.f, 0.f, 0.f};
    bf16x8 At[4][2], B0[2][2], B1[2][2];
    const char* cA = (const char*)g.A + (size_t)cur.pm * tstep; const char* cB = (const char*)g.Bt + (size_t)cur.pn * tstep;
    S.a_ready(cur);
    if constexpr (SP2) {
        PG8_STAGE(PG8_SB(0, 0), cB, voffB); PG8_STAGE(PG8_SB(0, 1), cB + hstep, voffB); PG8_STAGE(PG8_SA(0, 0), cA, voffA); PG8_STAGE(PG8_SA(0, 1), cA + hstep, voffA);
        if (wr == 1) PG8_BAR;
        PG8_WAIT_V(2); PG8_BAR;
        PG8_STAGE(PG8_SB(1, 0), cB + kstep, voffB); PG8_STAGE(PG8_SA(1, 0), cA + kstep, voffA); PG8_STAGE(PG8_SB(1, 1), cB + hstep + kstep, voffB);
        PG8_WAIT_V(6); PG8_BAR;
    } else {
        PG8_STAGE(PG8_SB(0, 0), cB, voffB); PG8_STAGE(PG8_SA(0, 0), cA, voffA); PG8_STAGE(PG8_SB(0, 1), cB + hstep, voffB); PG8_STAGE(PG8_SA(0, 1), cA + hstep, voffA);
        if (wr == 1) PG8_BAR;
        PG8_WAIT_V(4); PG8_BAR;
        PG8_STAGE(PG8_SB(1, 0), cB + kstep, voffB); PG8_STAGE(PG8_SA(1, 0), cA + kstep, voffA); PG8_STAGE(PG8_SB(1, 1), cB + hstep + kstep, voffB);
        PG8_WAIT_V(6); PG8_BAR;
    }
    for (;;) {
        const bool has_next = S.next(ui + 1, nxt);
        const char* nA = has_next ? (const char*)g.A + (size_t)nxt.pm * tstep : cA; const char* nB = has_next ? (const char*)g.Bt + (size_t)nxt.pn * tstep : cB;
        for (int t = 0; t < nt; t += 2) {
            const bool last = (t == nt - 2);
            const char* a1 = cA + (size_t)(t + 1) * kstep;
            const char* a2 = last ? nA : cA + (size_t)(t + 2) * kstep; const char* b2 = last ? nB : cB + (size_t)(t + 2) * kstep;
            const char* a3 = a2 + kstep; const char* b3 = b2 + kstep;
            if (last && has_next) S.a_ready(nxt);
            if constexpr (SP2) {
            PG8_LDB(B0, 0, 0); PG8_LDB(B1, 0, 1); PG8_SCHED; PG8_LDA(At, 0, 0); PG8_STAGE(PG8_SA(1, 1), a1 + hstep, voffA);
            PG8_WAIT_V(8); PG8_WAIT_L(0); PG8_BAR; PG8_MMA(0, 0, At, B0); PG8_MMA(0, 1, At, B1); PG8_BAR; PG8_SCHED;
            PG8_LDA(At, 0, 1); PG8_STAGE(PG8_SB(0, 0), b2, voffB); PG8_STAGE(PG8_SB(0, 1), b2 + hstep, voffB); PG8_STAGE(PG8_SA(0, 0), a2, voffA);
            PG8_WAIT_V(8); PG8_WAIT_L(0); PG8_BAR; PG8_MMA(1, 0, At, B0); PG8_MMA(1, 1, At, B1); PG8_BAR; PG8_SCHED;
            PG8_LDB(B0, 1, 0); PG8_LDB(B1, 1, 1); PG8_SCHED; PG8_LDA(At, 1, 0); PG8_STAGE(PG8_SA(0, 1), a2 + hstep, voffA);
            PG8_WAIT_V(8); PG8_WAIT_L(0); PG8_BAR; PG8_MMA(0, 0, At, B0); PG8_MMA(0, 1, At, B1); PG8_BAR; PG8_SCHED;
            PG8_LDA(At, 1, 1); PG8_STAGE(PG8_SB(1, 0), b3, voffB); PG8_STAGE(PG8_SB(1, 1), b3 + hstep, voffB); PG8_STAGE(PG8_SA(1, 0), a3, voffA);
            PG8_WAIT_V(8); PG8_WAIT_L(0); PG8_BAR; PG8_MMA(1, 0, At, B0); PG8_MMA(1, 1, At, B1); PG8_BAR; PG8_SCHED;
            } else {
            PG8_LDB(B0, 0, 0); PG8_SCHED; PG8_LDA(At, 0, 0); PG8_STAGE(PG8_SA(1, 1), a1 + hstep, voffA);
            PG8_WAIT_L(8); PG8_BAR; PG8_WAIT_L(0); PG8_MMA(0, 0, At, B0); PG8_BAR; PG8_SCHED;
            PG8_LDB(B1, 0, 1); PG8_STAGE(PG8_SB(0, 0), b2, voffB);
            PG8_BAR; PG8_WAIT_L(0); PG8_MMA(0, 1, At, B1); PG8_BAR;
            PG8_LDA(At, 0, 1); PG8_STAGE(PG8_SA(0, 0), a2, voffA);
            PG8_BAR; PG8_WAIT_L(0); PG8_MMA(1, 0, At, B0); PG8_BAR; PG8_SCHED;
            PG8_STAGE(PG8_SB(0, 1), b2 + hstep, voffB);
            PG8_WAIT_V(6); PG8_BAR; PG8_MMA(1, 1, At, B1); PG8_BAR;
            PG8_LDB(B0, 1, 0); PG8_SCHED; PG8_LDA(At, 1, 0); PG8_STAGE(PG8_SA(0, 1), a2 + hstep, voffA);
            PG8_WAIT_L(8); PG8_BAR; PG8_WAIT_L(0); PG8_MMA(0, 0, At, B0); PG8_BAR; PG8_SCHED;
            PG8_LDB(B1, 1, 1); PG8_STAGE(PG8_SB(1, 0), b3, voffB);
            PG8_BAR; PG8_WAIT_L(0); PG8_MMA(0, 1, At, B1); PG8_BAR;
            PG8_LDA(At, 1, 1); PG8_STAGE(PG8_SA(1, 0), a3, voffA);
            PG8_BAR; PG8_WAIT_L(0); PG8_MMA(1, 0, At, B0); PG8_BAR; PG8_SCHED;
            PG8_STAGE(PG8_SB(1, 1), b3 + hstep, voffB);
            PG8_WAIT_V(6); PG8_BAR; PG8_MMA(1, 1, At, B1); PG8_BAR;
            }
        }
        if constexpr (ALIGN_EPI) { if (wr == 0) PG8_BAR; }
        if constexpr (!Epi::AFTER_DRAIN) { E(acc, cur, wr, wc, fr, fq); S.done(cur); }
        if (!has_next) break;
#pragma unroll
        for (int a = 0; a < 2; ++a)
#pragma unroll
            for (int b = 0; b < 2; ++b)
#pragma unroll
                for (int m = 0; m < 4; ++m)
#pragma unroll
                    for (int n = 0; n < 2; ++n) acc[a][b][m][n] = (f32x4){0.f, 0.f, 0.f, 0.f};
        cur = nxt; cA = nA; cB = nB; ++ui;
        if constexpr (ALIGN_EPI) { if (wr == 1) PG8_BAR; }
    }
    PG8_WAIT_V(0);
    if constexpr (!ALIGN_EPI) { if (wr == 0) PG8_BAR; }
    PG8_BAR;
    if constexpr (Epi::AFTER_DRAIN) { E.fused(acc, cur, wr, wc, fr, fq, lds, wid, lane); S.done(cur); }
#undef PG8_SA
#undef PG8_SB
#undef PG8_STAGE
#undef PG8_LDA
#undef PG8_LDB
#undef PG8_MMA
#undef PG8_WAIT_V
#undef PG8_WAIT_L
#undef PG8_BAR
#undef PG8_SCHED
}
}

typedef unsigned short bf16_t;
typedef short bf16x8 __attribute__((ext_vector_type(8)));
typedef short s16x4 __attribute__((ext_vector_type(4)));
typedef float f32x4 __attribute__((ext_vector_type(4)));
typedef float f32x2v __attribute__((ext_vector_type(2)));
typedef __bf16 bf16x2_t __attribute__((ext_vector_type(2)));
typedef unsigned u32x4 __attribute__((ext_vector_type(4)));
typedef unsigned u32x2 __attribute__((ext_vector_type(2)));

constexpr int DM = 1024;
constexpr int NPROMPT = 32 * 2048;
constexpr int NSAMPLE = 32 * 16;
constexpr int NROWS = NPROMPT + NSAMPLE;
constexpr int SEQ = 2048, DEC_SEQ = 16, PAST = 1024, KVS_ROWS = 1088;
constexpr int H1W = 3072;
constexpr int NWIN = 3328;
constexpr int DFF = 4096;
constexpr float ALPHA = 1.4142135623730951f;
constexpr float LAMBDA_INIT = 0.35550906759096934f;
constexpr float LN_EPS = 1e-5f, RMS_EPS = 1e-5f;
constexpr float QSCALE_B = 0.18033688011112042f;
constexpr float QSCALE_A = 0.08838834764831845f;

constexpr size_t MiB = 1u << 20;
constexpr size_t WS_WIN = 0, WS_WOA = 7 * MiB, WS_WKVQ = 9 * MiB, WS_WOB = 15 * MiB, WS_WUP0 = 17 * MiB, WS_WUP1 = 25 * MiB,
                 WS_WDN0 = 33 * MiB, WS_WDN1 = 41 * MiB, WS_ROPE = 49 * MiB, WS_GL = 50 * MiB, WS_XB = 56 * MiB,
                 WS_KS = 186 * MiB, WS_VS = 254 * MiB, WS_BIG = 322 * MiB;
constexpr size_t BIG_H1 = 0, BIG_OG = (size_t)NROWS * H1W * 2, BIG_U = 0, BIG_KB = 0, BIG_VB = 128 * MiB, BIG_QB = 256 * MiB, BIG_OB = 385 * MiB;
constexpr size_t WS_END = WS_BIG + 516 * MiB;
static_assert(BIG_OG + (size_t)NROWS * DM * 2 <= 516 * MiB, "big region");
static_assert(BIG_OB + (size_t)NROWS * DM * 2 <= 516 * MiB, "big region");
static_assert((size_t)NROWS * DFF * 2 <= 516 * MiB, "big region");

constexpr size_t OUT_Y = 0, OUT_SP = 67633152, OUT_KP = 71827456, OUT_VP = 138936320, OUT_SS = 206045184, OUT_KSMP = 210239488, OUT_VSMP = 210763776;

constexpr int NTHREADS = 512, NWAVES = 8;
constexpr int LDS_BYTES = 147456;

#define DI __device__ __forceinline__
DI unsigned cvtpk(float lo, float hi) { f32x2v v = {lo, hi}; bf16x2_t b = __builtin_convertvector(v, bf16x2_t); return __builtin_bit_cast(unsigned, b); }
DI float bf2f(unsigned short h) { return __uint_as_float(((unsigned)h) << 16); }
DI float bflo(unsigned w) { return __uint_as_float(w << 16); }
DI float bfhi(unsigned w) { return __uint_as_float(w & 0xffff0000u); }
DI bf16x8 pack8(f32x4 a, f32x4 b) { u32x4 p; p.x = cvtpk(a[0], a[1]); p.y = cvtpk(a[2], a[3]); p.z = cvtpk(b[0], b[1]); p.w = cvtpk(b[2], b[3]); return __builtin_bit_cast(bf16x8, p); }
#define MFMA16(a, b, c) __builtin_amdgcn_mfma_f32_16x16x32_bf16((a), (b), (c), 0, 0, 0)

struct Params { const float* in[19]; float* out; unsigned char* ws; int ph_lo, ph_hi; };

struct EpiH1 {
    static constexpr bool PERM = true, AFTER_DRAIN = false;
    bf16_t* H1; float* GL;
    DI void operator()(const pg8::f32x4 (&acc)[2][2][4][2], const pg8::Unit& u, int wr, int wc, int fr, int fq) const {
        const int row0 = u.pm * 256 + wr * 64 + fr;
        if (u.pn < 12) {
            const float sc = (u.pn < 2) ? QSCALE_A : 1.0f;
            const int col0 = u.pn * 256 + wc * 32 + 8 * fq;
#pragma unroll
            for (int ai = 0; ai < 2; ++ai)
#pragma unroll
                for (int m = 0; m < 4; ++m) { bf16_t* rowp = H1 + (size_t)(row0 + ai * 128 + m * 16) * H1W + col0;
#pragma unroll
                    for (int bj = 0; bj < 2; ++bj) { f32x4 v0 = acc[ai][bj][m][0] * sc, v1 = acc[ai][bj][m][1] * sc; u32x4 w;
                        w.x = cvtpk(v0[0], v0[1]); w.y = cvtpk(v0[2], v0[3]); w.z = cvtpk(v1[0], v1[1]); w.w = cvtpk(v1[2], v1[3]);
                        *(u32x4*)(rowp + bj * 128) = w; } }
        } else {
            if (wc == 0 && fq < 2) {
#pragma unroll
                for (int ai = 0; ai < 2; ++ai)
#pragma unroll
                    for (int m = 0; m < 4; ++m) { float* rowp = GL + (size_t)(row0 + ai * 128 + m * 16) * 16 + 8 * fq;
                        *(f32x4*)(rowp) = acc[ai][0][m][0]; *(f32x4*)(rowp + 4) = acc[ai][0][m][1]; }
            }
        }
    }
};
struct EpiRes {
    static constexpr bool PERM = false, AFTER_DRAIN = false;
    float* XR;
    DI void operator()(const pg8::f32x4 (&acc)[2][2][4][2], const pg8::Unit& u, int wr, int wc, int fr, int fq) const {
        const int row0 = u.pm * 256 + wr * 64 + fr, col0 = u.pn * 256 + wc * 32 + 4 * fq;
#pragma unroll
        for (int ai = 0; ai < 2; ++ai)
#pragma unroll
            for (int m = 0; m < 4; ++m) { float* rowp = XR + (size_t)(row0 + ai * 128 + m * 16) * DM + col0;
#pragma unroll
                for (int bj = 0; bj < 2; ++bj)
#pragma unroll
                    for (int n = 0; n < 2; ++n) { float* p = rowp + bj * 128 + n * 16; const f32x4 b = *(const f32x4*)p; *(f32x4*)p = b * ALPHA + acc[ai][bj][m][n]; } }
    }
};
struct EpiUp {
    static constexpr bool PERM = true, AFTER_DRAIN = false;
    bf16_t* U;
    DI void operator()(const pg8::f32x4 (&acc)[2][2][4][2], const pg8::Unit& u, int wr, int wc, int fr, int fq) const {
        const int row0 = u.pm * 256 + wr * 64 + fr, col0 = u.pn * 256 + wc * 32 + 8 * fq;
#pragma unroll
        for (int ai = 0; ai < 2; ++ai)
#pragma unroll
            for (int m = 0; m < 4; ++m) { bf16_t* rowp = U + (size_t)(row0 + ai * 128 + m * 16) * DFF + col0;
#pragma unroll
                for (int bj = 0; bj < 2; ++bj) { f32x4 v0 = acc[ai][bj][m][0], v1 = acc[ai][bj][m][1];
#pragma unroll
                    for (int i = 0; i < 4; ++i) { float a = fmaxf(v0[i], 0.f), b = fmaxf(v1[i], 0.f); v0[i] = a * a; v1[i] = b * b; }
                    u32x4 w; w.x = cvtpk(v0[0], v0[1]); w.y = cvtpk(v0[2], v0[3]); w.z = cvtpk(v1[0], v1[1]); w.w = cvtpk(v1[2], v1[3]);
                    *(u32x4*)(rowp + bj * 128) = w; } }
    }
};
struct EpiKVQ {
    static constexpr bool PERM = false, AFTER_DRAIN = false;
    float* out; bf16_t *KB, *VB, *QB, *KS, *VS; const float* rope;
    DI void operator()(const pg8::f32x4 (&acc)[2][2][4][2], const pg8::Unit& u, int wr, int wc, int fr, int fq) const {
        const int kind = u.pn >> 2;
        const int colt = (u.pn & 3) * 256 + wc * 32 + 4 * fq;
        const bool do_rope = (kind != 1) && ((wc & 1) == 0);
#pragma unroll
        for (int ai = 0; ai < 2; ++ai)
#pragma unroll
            for (int m = 0; m < 4; ++m) {
                const int row = u.pm * 256 + wr * 64 + fr + ai * 128 + m * 16;
                const bool smp = row >= NPROMPT; const int rs = row - NPROMPT;
                const int pos = smp ? (PAST + (rs & 15)) : (row & (SEQ - 1));
                float* of; bf16_t* ob;
                if (kind == 0) { of = smp ? out + OUT_KSMP + (size_t)rs * DM : out + OUT_KP + (size_t)row * DM;
                                 ob = smp ? KS + ((size_t)(rs >> 4) * KVS_ROWS + PAST + (rs & 15)) * DM : KB + (size_t)row * DM; }
                else if (kind == 1) { of = smp ? out + OUT_VSMP + (size_t)rs * DM : out + OUT_VP + (size_t)row * DM;
                                 ob = smp ? VS + ((size_t)(rs >> 4) * KVS_ROWS + PAST + (rs & 15)) * DM : VB + (size_t)row * DM; }
                else { of = nullptr; ob = QB + (size_t)row * DM; }
#pragma unroll
                for (int bj = 0; bj < 2; ++bj)
#pragma unroll
                    for (int n = 0; n < 2; ++n) {
                        f32x4 v = acc[ai][bj][m][n];
                        if (n == 0 && do_rope) {
                            f32x4 pr; pr[0] = __shfl_xor(v[0], 32); pr[1] = __shfl_xor(v[1], 32); pr[2] = __shfl_xor(v[2], 32); pr[3] = __shfl_xor(v[3], 32);
                            const float* rp = rope + (size_t)pos * 16 + 8 * (fq & 1);
                            const f32x4 cs0 = *(const f32x4*)rp, cs1 = *(const f32x4*)(rp + 4);
                            const float sg = (fq < 2) ? -1.f : 1.f;
                            v[0] = v[0] * cs0[0] + sg * pr[0] * cs0[1]; v[1] = v[1] * cs0[2] + sg * pr[1] * cs0[3];
                            v[2] = v[2] * cs1[0] + sg * pr[2] * cs1[1]; v[3] = v[3] * cs1[2] + sg * pr[3] * cs1[3];
                        }
                        const int col = colt + bj * 128 + n * 16;
                        if (kind == 2) v = v * QSCALE_B; else *(f32x4*)(of + col) = v;
                        u32x2 w; w.x = cvtpk(v[0], v[1]); w.y = cvtpk(v[2], v[3]); *(u32x2*)(ob + col) = w;
                    }
            }
    }
};

DI float wave_sum(float v) {
#pragma unroll
    for (int o = 1; o < 64; o <<= 1) v += __shfl_xor(v, o);
    return v;
}
DI void transpose_item(const float* W, int ldw, int col0, int K, int ncols, bf16_t* WT, int row_off, float* scr, int item, int lane) {
    const int nblk = ncols / 32, kb = item / nblk, nb = item % nblk, k0 = 64 * kb, n0 = 32 * nb;
#pragma unroll 8
    for (int i = 0; i < 32; ++i) { const int kk = 2 * i + (lane >> 5); scr[kk * 33 + (lane & 31)] = W[(size_t)(k0 + kk) * ldw + col0 + n0 + (lane & 31)]; }
    asm volatile("s_waitcnt lgkmcnt(0)" ::: "memory");
    const int c = lane & 7;
#pragma unroll
    for (int j = 0; j < 4; ++j) { const int n = (lane >> 3) + 8 * j; const float* s = scr + (8 * c) * 33 + n;
        u32x4 o; o.x = cvtpk(s[0 * 33], s[1 * 33]); o.y = cvtpk(s[2 * 33], s[3 * 33]); o.z = cvtpk(s[4 * 33], s[5 * 33]); o.w = cvtpk(s[6 * 33], s[7 * 33]);
        *(u32x4*)(WT + (size_t)(row_off + n0 + n) * K + k0 + 8 * c) = o; }
    asm volatile("s_waitcnt lgkmcnt(0)" ::: "memory");
}
DI void cvt_row(const float* src, bf16_t* dstb, float* dstf, int lane) {
    const f32x4* s = (const f32x4*)src + lane;
    f32x4 v[4];
#pragma unroll
    for (int j = 0; j < 4; ++j) v[j] = s[64 * j];
    u32x2* o = (u32x2*)dstb + lane;
#pragma unroll
    for (int j = 0; j < 4; ++j) { u32x2 w; w.x = cvtpk(v[j][0], v[j][1]); w.y = cvtpk(v[j][2], v[j][3]); o[64 * j] = w; }
    if (dstf) { f32x4* f = (f32x4*)dstf + lane;
#pragma unroll
        for (int j = 0; j < 4; ++j) f[64 * j] = v[j]; }
}

DI void phase_prep(const Params& p, unsigned char* lds, int gw, int ngw, int wave, int lane) {
    unsigned char* ws = p.ws;
    float* scr = (float*)(lds + wave * 16384);
    constexpr int I_IN = 16 * 96, I_SQ = 16 * 32, I_KV = 16 * 64, I_UP = 16 * 128, I_DN = 64 * 32;
    constexpr int NIT = I_IN + I_SQ + I_KV + I_SQ + I_SQ + 2 * I_UP + 2 * I_DN;
    for (int it = gw; it < NIT; it += ngw) {
        int r = it;
        if (r < I_IN) { transpose_item(p.in[5], 3088, 0, 1024, 3072, (bf16_t*)(ws + WS_WIN), 0, scr, r, lane); continue; } r -= I_IN;
        if (r < I_SQ) { transpose_item(p.in[9], 1024, 0, 1024, 1024, (bf16_t*)(ws + WS_WOA), 0, scr, r, lane); continue; } r -= I_SQ;
        if (r < I_KV) { transpose_item(p.in[10], 2048, 0, 1024, 2048, (bf16_t*)(ws + WS_WKVQ), 0, scr, r, lane); continue; } r -= I_KV;
        if (r < I_SQ) { transpose_item(p.in[11], 1024, 0, 1024, 1024, (bf16_t*)(ws + WS_WKVQ), 2048, scr, r, lane); continue; } r -= I_SQ;
        if (r < I_SQ) { transpose_item(p.in[14], 1024, 0, 1024, 1024, (bf16_t*)(ws + WS_WOB), 0, scr, r, lane); continue; } r -= I_SQ;
        if (r < I_UP) { transpose_item(p.in[15], 4096, 0, 1024, 4096, (bf16_t*)(ws + WS_WUP0), 0, scr, r, lane); continue; } r -= I_UP;
        if (r < I_UP) { transpose_item(p.in[15] + (size_t)1024 * 4096, 4096, 0, 1024, 4096, (bf16_t*)(ws + WS_WUP1), 0, scr, r, lane); continue; } r -= I_UP;
        if (r < I_DN) { transpose_item(p.in[16], 1024, 0, 4096, 1024, (bf16_t*)(ws + WS_WDN0), 0, scr, r, lane); continue; } r -= I_DN;
        transpose_item(p.in[16] + (size_t)4096 * 1024, 1024, 0, 4096, 1024, (bf16_t*)(ws + WS_WDN1), 0, scr, r, lane);
    }
    for (int rr = gw; rr < 256; rr += ngw) {
        bf16_t* dst = (bf16_t*)(ws + WS_WIN) + (size_t)(3072 + rr) * 1024;
        for (int k = lane; k < 1024; k += 64) { const float v = (rr < 16) ? p.in[5][(size_t)k * 3088 + 3072 + rr] : 0.f; dst[k] = (bf16_t)(cvtpk(v, 0.f) & 0xffffu); }
    }
    for (int r = gw; r < NROWS; r += ngw) {
        const float* src = (r < NPROMPT) ? p.in[0] + (size_t)r * DM : p.in[1] + (size_t)(r - NPROMPT) * DM;
        cvt_row(src, (bf16_t*)(ws + WS_XB) + (size_t)r * DM, p.out + (size_t)r * DM, lane);
    }
    for (int r = gw; r < 2 * 32 * KVS_ROWS; r += ngw) {
        const int which = r / (32 * KVS_ROWS), rr = r % (32 * KVS_ROWS), b = rr / KVS_ROWS, t = rr % KVS_ROWS;
        bf16_t* dst = (bf16_t*)(ws + (which ? WS_VS : WS_KS)) + (size_t)rr * DM;
        if (t < PAST) cvt_row(p.in[which ? 4 : 3] + ((size_t)b * PAST + t) * DM, dst, nullptr, lane);
        else if (t >= PAST + DEC_SEQ) { u32x4 z = {0u, 0u, 0u, 0u}; ((u32x4*)dst)[lane] = z; ((u32x4*)dst)[lane + 64] = z; }
    }
    {
        const double invrev[8] = {0.15915494309189535, 0.03086376340470123, 0.005985185712713705, 0.0011606636412400608,
                                  0.00022507907903927653, 4.364795279280289e-05, 8.464330808241401e-06, 1.6414262627950345e-06};
        float* tab = (float*)(ws + WS_ROPE);
        for (int idx = gw * 64 + lane; idx < 2048 * 8; idx += ngw * 64) {
            const int pos = idx >> 3, i = idx & 7;
            double iv = invrev[0];
#pragma unroll
            for (int q = 1; q < 8; ++q) iv = (i == q) ? invrev[q] : iv;
            const double rev = (double)pos * iv; const float fr = (float)(rev - rint(rev));
            tab[2 * idx] = __builtin_amdgcn_cosf(fr); tab[2 * idx + 1] = __builtin_amdgcn_sinf(fr);
        }
    }
}

DI void phase_ln(float* XR, bf16_t* XB, const float* g, const float* b, int gw, int ngw, int lane) {
    f32x4 gv[4], bv[4];
#pragma unroll
    for (int j = 0; j < 4; ++j) { gv[j] = ((const f32x4*)g)[lane + 64 * j]; bv[j] = ((const f32x4*)b)[lane + 64 * j]; }
    for (int r = gw; r < NROWS; r += ngw) {
        f32x4* xr = (f32x4*)(XR + (size_t)r * DM) + lane;
        f32x4 v[4]; float s = 0.f;
#pragma unroll
        for (int j = 0; j < 4; ++j) { v[j] = xr[64 * j]; s += (v[j][0] + v[j][1]) + (v[j][2] + v[j][3]); }
        const float mean = wave_sum(s) * (1.f / DM); float s2 = 0.f;
#pragma unroll
        for (int j = 0; j < 4; ++j) { v[j] = v[j] - mean; s2 += (v[j][0] * v[j][0] + v[j][1] * v[j][1]) + (v[j][2] * v[j][2] + v[j][3] * v[j][3]); }
        const float rstd = 1.f / sqrtf(wave_sum(s2) * (1.f / DM) + LN_EPS);
#pragma unroll
        for (int j = 0; j < 4; ++j) { v[j] = v[j] * rstd * gv[j] + bv[j]; xr[64 * j] = v[j]; }
        if (XB) { u32x2* o = (u32x2*)(XB + (size_t)r * DM) + lane;
#pragma unroll
            for (int j = 0; j < 4; ++j) { u32x2 w; w.x = cvtpk(v[j][0], v[j][1]); w.y = cvtpk(v[j][2], v[j][3]); o[64 * j] = w; } }
    }
}

DI void phase_ognorm(bf16_t* OG, const bf16_t* H1, const float* gn, int gw, int ngw, int lane) {
    float g[16];
#pragma unroll
    for (int j = 0; j < 4; ++j) { const f32x4 t = *(const f32x4*)(gn + (16 * lane) % 256 + 4 * j); g[4 * j] = t[0]; g[4 * j + 1] = t[1]; g[4 * j + 2] = t[2]; g[4 * j + 3] = t[3]; }
    for (int r = gw; r < NROWS; r += ngw) {
        u32x4* op = (u32x4*)(OG + (size_t)r * DM + 16 * lane);
        const u32x4* rp = (const u32x4*)(H1 + (size_t)r * H1W + 2048 + 16 * lane);
        const u32x4 o0 = op[0], o1 = op[1], r0 = rp[0], r1 = rp[1];
        float o[16], rr[16];
#pragma unroll
        for (int j = 0; j < 4; ++j) { o[2 * j] = bflo(o0[j]); o[2 * j + 1] = bfhi(o0[j]); o[8 + 2 * j] = bflo(o1[j]); o[8 + 2 * j + 1] = bfhi(o1[j]);
            rr[2 * j] = bflo(r0[j]); rr[2 * j + 1] = bfhi(r0[j]); rr[8 + 2 * j] = bflo(r1[j]); rr[8 + 2 * j + 1] = bfhi(r1[j]); }
        float ss = 0.f;
#pragma unroll
        for (int j = 0; j < 16; ++j) ss += o[j] * o[j];
        ss += __shfl_xor(ss, 1); ss += __shfl_xor(ss, 2); ss += __shfl_xor(ss, 4); ss += __shfl_xor(ss, 8);
        const float rstd = 1.f / sqrtf(ss * (1.f / 256.f) + RMS_EPS);
#pragma unroll
        for (int j = 0; j < 16; ++j) { const float x = rr[j]; o[j] = o[j] * rstd * g[j] * (x / (1.f + __expf(-x))); }
        u32x4 w0, w1;
#pragma unroll
        for (int j = 0; j < 4; ++j) { w0[j] = cvtpk(o[2 * j], o[2 * j + 1]); w1[j] = cvtpk(o[8 + 2 * j], o[8 + 2 * j + 1]); }
        op[0] = w0; op[1] = w1;
    }
}

template <int C>
DI void gla_unit(unsigned char* lds, const bf16_t* H1, const float* GL, bf16_t* OG, size_t row0, int nchunks, int h, int half,
                 const float* S_init, float* S_out, const float* Wg, const float* bg) {
    constexpr int CP = (C < 32) ? 32 : C, PT = CP + 8, TPG = C / 4, QP = 136;
    const int tid = threadIdx.x, lane = tid & 63, w = __builtin_amdgcn_readfirstlane(tid >> 6), fr = lane & 15, fq = lane >> 4;
    float* GLS = (float*)(lds);
    float* TOT = (float*)(lds + 4096);
    float* DEC = (float*)(lds + 6144);
    bf16_t* VT = (bf16_t*)(lds + 8192);
    bf16_t* KT = (bf16_t*)(lds + 26624);
    bf16_t* QF = (bf16_t*)(lds + 45056);
    bf16_t* KF = (bf16_t*)(lds + 62464);
    bf16_t* ATT = (bf16_t*)(lds + 79872);
    __syncthreads();
    if (C < 32) { for (int i = tid; i < (89088 - 8192) / 16; i += NTHREADS) ((u32x4*)(lds + 8192))[i] = (u32x4){0u, 0u, 0u, 0u}; __syncthreads(); }
    const int dk = tid & 127, g = tid >> 7;
    float wg[16];
#pragma unroll
    for (int r = 0; r < 16; ++r) wg[r] = Wg[r * 512 + h * 128 + dk];
    const float bgv = bg[h * 128 + dk];
    const int vcol = half * 128 + 16 * w + fr;
    f32x4 S[8];
#pragma unroll
    for (int t = 0; t < 8; ++t)
#pragma unroll
        for (int r = 0; r < 4; ++r) S[t][r] = S_init ? S_init[(size_t)(16 * t + 4 * fq + r) * 256 + vcol] : 0.f;

    for (int ch = 0; ch < nchunks; ++ch) {
        const size_t rbase = row0 + (size_t)ch * C;
        if (tid < C * 4) ((f32x4*)GLS)[tid] = ((const f32x4*)(GL + rbase * 16))[tid];
#pragma unroll
        for (int it = 0; it < (C * 16 + NTHREADS - 1) / NTHREADS; ++it) {
            const int item = tid + NTHREADS * it;
            if (item < C * 16) {
                const int cc = item / C, j = item % C;
                const u32x4 v = *(const u32x4*)(H1 + (rbase + j) * H1W + 1024 + h * 256 + half * 128 + cc * 8);
#pragma unroll
                for (int e = 0; e < 4; ++e) { VT[(8 * cc + 2 * e) * PT + j] = (bf16_t)(v[e] & 0xffffu); VT[(8 * cc + 2 * e + 1) * PT + j] = (bf16_t)(v[e] >> 16); }
            }
        }
        bf16_t qraw[TPG], kraw[TPG];
#pragma unroll
        for (int ii = 0; ii < TPG; ++ii) { const size_t rr = (rbase + g * TPG + ii) * H1W + h * 128 + dk; qraw[ii] = H1[rr]; kraw[ii] = H1[rr + 512]; }
        __syncthreads();
        float bl[TPG]; float run = 0.f;
#pragma unroll
        for (int ii = 0; ii < TPG; ++ii) {
            const float* gr = GLS + (g * TPG + ii) * 16; float lg = bgv;
#pragma unroll
            for (int r = 0; r < 16; ++r) lg += gr[r] * wg[r];
            const float ls = fminf(lg, 0.f) - __logf(1.f + __expf(-fabsf(lg)));
            run += ls * (1.f / 16.f); bl[ii] = run;
        }
        TOT[g * 128 + dk] = run;
        __syncthreads();
        float off = 0.f, blast = 0.f;
#pragma unroll
        for (int gg = 0; gg < 4; ++gg) { const float t = TOT[gg * 128 + dk]; blast += t; off += (gg < g) ? t : 0.f; }
#pragma unroll
        for (int ii = 0; ii < TPG; ++ii) {
            const int i = g * TPG + ii; const float b = off + bl[ii];
            const float qv = bf2f(qraw[ii]), kv = bf2f(kraw[ii]);
            QF[i * QP + dk] = (bf16_t)(cvtpk(qv * __expf(b), 0.f) & 0xffffu);
            KF[i * QP + dk] = (bf16_t)(cvtpk(kv * __expf(-b), 0.f) & 0xffffu);
            KT[dk * PT + i] = (bf16_t)(cvtpk(kv * __expf(blast - b), 0.f) & 0xffffu);
        }
        if (g == 0) DEC[dk] = __expf(blast);
        __syncthreads();
        {
            constexpr int NT = C / 16;
            if (C == 64 || w == 0) {
                const int ti = (C == 64) ? (w >> 1) : 0;
#pragma unroll
                for (int q = 0; q < ((C == 64) ? 2 : 1); ++q) {
                    const int tj = (C == 64) ? (2 * (w & 1) + q) : 0;
                    f32x4 d = {0.f, 0.f, 0.f, 0.f};
                    if (tj <= ti) {
#pragma unroll
                        for (int s = 0; s < 4; ++s) { const bf16x8 a = *(const bf16x8*)(QF + (16 * ti + fr) * QP + 32 * s + 8 * fq); const bf16x8 bb = *(const bf16x8*)(KF + (16 * tj + fr) * QP + 32 * s + 8 * fq); d = MFMA16(a, bb, d); }
                    }
#pragma unroll
                    for (int r = 0; r < 4; ++r) { const int i = 16 * ti + 4 * fq + r, j = 16 * tj + fr; ATT[i * PT + j] = (bf16_t)(cvtpk((j <= i) ? d[r] : 0.f, 0.f) & 0xffffu); }
                }
            }
            f32x4 o[NT];
            bf16x8 sf[4];
#pragma unroll
            for (int s = 0; s < 4; ++s) sf[s] = pack8(S[2 * s], S[2 * s + 1]);
#pragma unroll
            for (int ti = 0; ti < NT; ++ti) { o[ti] = (f32x4){0.f, 0.f, 0.f, 0.f};
#pragma unroll
                for (int s = 0; s < 4; ++s) { const s16x4 lo = *(const s16x4*)(QF + (16 * ti + fr) * QP + 32 * s + 4 * fq), hi = *(const s16x4*)(QF + (16 * ti + fr) * QP + 32 * s + 16 + 4 * fq);
                    const bf16x8 a = __builtin_shufflevector(lo, hi, 0, 1, 2, 3, 4, 5, 6, 7); o[ti] = MFMA16(a, sf[s], o[ti]); } }
            __syncthreads();
#pragma unroll
            for (int ti = 0; ti < NT; ++ti) {
#pragma unroll
                for (int s = 0; s < CP / 32; ++s) { const bf16x8 a = *(const bf16x8*)(ATT + (16 * ti + fr) * PT + 32 * s + 8 * fq); const bf16x8 bb = *(const bf16x8*)(VT + (16 * w + fr) * PT + 32 * s + 8 * fq); o[ti] = MFMA16(a, bb, o[ti]); }
#pragma unroll
                for (int r = 0; r < 4; ++r) OG[(rbase + 16 * ti + 4 * fq + r) * DM + h * 256 + vcol] = (bf16_t)(cvtpk(o[ti][r], 0.f) & 0xffffu);
            }
#pragma unroll
            for (int t = 0; t < 8; ++t) {
                const f32x4 dec = *(const f32x4*)(DEC + 16 * t + 4 * fq);
                S[t] = S[t] * dec;
#pragma unroll
                for (int s = 0; s < CP / 32; ++s) { const bf16x8 a = *(const bf16x8*)(KT + (16 * t + fr) * PT + 32 * s + 8 * fq); const bf16x8 bb = *(const bf16x8*)(VT + (16 * w + fr) * PT + 32 * s + 8 * fq); S[t] = MFMA16(a, bb, S[t]); }
            }
        }
        __syncthreads();
    }
#pragma unroll
    for (int t = 0; t < 8; ++t)
#pragma unroll
        for (int r = 0; r < 4; ++r) S_out[(size_t)(16 * t + 4 * fq + r) * 256 + vcol] = S[t][r];
}

DI void attn_unit(unsigned char* lds, const bf16_t* Qp, const bf16_t* Kp, const bf16_t* Vp, bf16_t* Op, int nt_lo, int nt_hi, int kv_len, bool only_w0,
                  float lam, const float* gn) {
    constexpr int KP = 136, VP = 72;
    const int tid = threadIdx.x, lane = tid & 63, w = __builtin_amdgcn_readfirstlane(tid >> 6), fr = lane & 15, fq = lane >> 4;
    bf16_t* KS = (bf16_t*)lds;
    bf16_t* VT = (bf16_t*)(lds + 17408);
    const bool wact = only_w0 ? (w == 0) : true;
    const int my_nt = (w < 4) ? nt_lo : nt_hi;
    bf16x8 qf[2][2];
#pragma unroll
    for (int m = 0; m < 2; ++m)
#pragma unroll
        for (int s = 0; s < 2; ++s) qf[m][s] = wact ? *(const bf16x8*)(Qp + (size_t)(16 * w + fr) * DM + m * 64 + 32 * s + 8 * fq) : (bf16x8){0, 0, 0, 0, 0, 0, 0, 0};
    f32x4 O[2][8];
#pragma unroll
    for (int m = 0; m < 2; ++m)
#pragma unroll
        for (int n = 0; n < 8; ++n) O[m][n] = (f32x4){0.f, 0.f, 0.f, 0.f};
    float mrun[2] = {-INFINITY, -INFINITY}, lsum[2] = {0.f, 0.f};
    u32x4 kreg[2], vreg[2];
    const int kkey = tid >> 4, kch = tid & 15;
    const int vcc = tid >> 6, vkey = tid & 63;
    const bf16_t* kptr = Kp + (size_t)kkey * DM + kch * 8;
    const bf16_t* vptr = Vp + (size_t)vkey * DM + vcc * 8;
#pragma unroll
    for (int it = 0; it < 2; ++it) { kreg[it] = *(const u32x4*)(kptr + (size_t)it * 32 * DM); vreg[it] = *(const u32x4*)(vptr + it * 64); }
    __syncthreads();
    for (int t = 0; t < nt_hi; ++t) {
#pragma unroll
        for (int it = 0; it < 2; ++it) {
            *(u32x4*)(KS + (kkey + 32 * it) * KP + kch * 8) = kreg[it];
#pragma unroll
            for (int e = 0; e < 4; ++e) { VT[(8 * (vcc + 8 * it) + 2 * e) * VP + vkey] = (bf16_t)(vreg[it][e] & 0xffffu); VT[(8 * (vcc + 8 * it) + 2 * e + 1) * VP + vkey] = (bf16_t)(vreg[it][e] >> 16); }
        }
        __syncthreads();
        if (t + 1 < nt_hi) {
            kptr += (size_t)64 * DM; vptr += (size_t)64 * DM;
#pragma unroll
            for (int it = 0; it < 2; ++it) { kreg[it] = *(const u32x4*)(kptr + (size_t)it * 32 * DM); vreg[it] = *(const u32x4*)(vptr + it * 64); }
        }
        if (wact && t < my_nt) {
            f32x4 Sx[2][4];
#pragma unroll
            for (int m = 0; m < 2; ++m)
#pragma unroll
                for (int kk = 0; kk < 4; ++kk) { f32x4 a = {0.f, 0.f, 0.f, 0.f};
#pragma unroll
                    for (int s = 0; s < 2; ++s) { const bf16x8 kf = *(const bf16x8*)(KS + (16 * kk + fr) * KP + m * 64 + 32 * s + 8 * fq); a = MFMA16(kf, qf[m][s], a); }
                    Sx[m][kk] = a; }
            const int key0 = t * 64;
            if (key0 + 64 > kv_len) {
#pragma unroll
                for (int m = 0; m < 2; ++m)
#pragma unroll
                    for (int kk = 0; kk < 4; ++kk)
#pragma unroll
                        for (int r = 0; r < 4; ++r) if (key0 + 16 * kk + 4 * fq + r >= kv_len) Sx[m][kk][r] = -INFINITY;
            }
            bf16x8 pf[2][2];
#pragma unroll
            for (int m = 0; m < 2; ++m) {
                float mx = -INFINITY;
#pragma unroll
                for (int kk = 0; kk < 4; ++kk)
#pragma unroll
                    for (int r = 0; r < 4; ++r) mx = fmaxf(mx, Sx[m][kk][r]);
                mx = fmaxf(mx, __shfl_xor(mx, 16)); mx = fmaxf(mx, __shfl_xor(mx, 32));
                const float mnew = fmaxf(mrun[m], mx); const float corr = __builtin_amdgcn_exp2f(mrun[m] - mnew); mrun[m] = mnew;
                float ps = 0.f;
#pragma unroll
                for (int kk = 0; kk < 4; ++kk)
#pragma unroll
                    for (int r = 0; r < 4; ++r) { const float pv = __builtin_amdgcn_exp2f(Sx[m][kk][r] - mnew); Sx[m][kk][r] = pv; ps += pv; }
                lsum[m] = lsum[m] * corr + ps;
#pragma unroll
                for (int n = 0; n < 8; ++n) O[m][n] = O[m][n] * corr;
                pf[m][0] = pack8(Sx[m][0], Sx[m][1]); pf[m][1] = pack8(Sx[m][2], Sx[m][3]);
            }
#pragma unroll
            for (int n = 0; n < 8; ++n)
#pragma unroll
                for (int s = 0; s < 2; ++s) {
                    const s16x4 lo = *(const s16x4*)(VT + (16 * n + fr) * VP + 32 * s + 4 * fq), hi = *(const s16x4*)(VT + (16 * n + fr) * VP + 32 * s + 16 + 4 * fq);
                    const bf16x8 vf = __builtin_shufflevector(lo, hi, 0, 1, 2, 3, 4, 5, 6, 7);
                    O[0][n] = MFMA16(vf, pf[0][s], O[0][n]); O[1][n] = MFMA16(vf, pf[1][s], O[1][n]);
                }
        }
        __syncthreads();
    }
    if (wact) {
        float l0 = lsum[0], l1 = lsum[1];
        l0 += __shfl_xor(l0, 16); l0 += __shfl_xor(l0, 32); l1 += __shfl_xor(l1, 16); l1 += __shfl_xor(l1, 32);
        const float i0 = 1.f / l0, i1 = lam / l1;
        float ss = 0.f;
#pragma unroll
        for (int n = 0; n < 8; ++n)
#pragma unroll
            for (int r = 0; r < 4; ++r) { const float o = O[0][n][r] * i0 - O[1][n][r] * i1; O[0][n][r] = o; ss += o * o; }
        ss += __shfl_xor(ss, 16); ss += __shfl_xor(ss, 32);
        const float rstd = (1.f - LAMBDA_INIT) / sqrtf(ss * (1.f / 128.f) + RMS_EPS);
#pragma unroll
        for (int n = 0; n < 8; ++n) { const f32x4 gv = *(const f32x4*)(gn + 16 * n + 4 * fq); const f32x4 o = O[0][n] * gv * rstd;
            u32x2 wv; wv.x = cvtpk(o[0], o[1]); wv.y = cvtpk(o[2], o[3]); *(u32x2*)(Op + (size_t)(16 * w + fr) * DM + 16 * n + 4 * fq) = wv; }
    }
}

constexpr int NPHASE = 16;
__global__ void __launch_bounds__(NTHREADS) yoco_fwd(Params p) {
    extern __shared__ __attribute__((aligned(16))) unsigned char lds[];
    cg::grid_group grid = cg::this_grid();
    const int tid = threadIdx.x, lane = tid & 63, wave = __builtin_amdgcn_readfirstlane(tid >> 6);
    const int G = gridDim.x, bx = blockIdx.x;
    const int gw = bx * NWAVES + wave, ngw = G * NWAVES;
    unsigned char* ws = p.ws;
    bf16_t* XB = (bf16_t*)(ws + WS_XB);
    float* XR = p.out;
    float* GL = (float*)(ws + WS_GL);
    bf16_t* H1 = (bf16_t*)(ws + WS_BIG + BIG_H1);
    bf16_t* OG = (bf16_t*)(ws + WS_BIG + BIG_OG);
    bf16_t* U = (bf16_t*)(ws + WS_BIG + BIG_U);
    bf16_t* KB = (bf16_t*)(ws + WS_BIG + BIG_KB);
    bf16_t* VB = (bf16_t*)(ws + WS_BIG + BIG_VB);
    bf16_t* QB = (bf16_t*)(ws + WS_BIG + BIG_QB);
    bf16_t* OB = (bf16_t*)(ws + WS_BIG + BIG_OB);
    bf16_t* KSb = (bf16_t*)(ws + WS_KS);
    bf16_t* VSb = (bf16_t*)(ws + WS_VS);
    const int lo = p.ph_lo, hi = p.ph_hi;
#define IN(k) (lo <= (k) && (k) < hi)
#define SEAM(k) do { if (IN(k) && IN((k) + 1)) grid.sync(); } while (0)
#define LDSP ((PG8_LAS unsigned char*)lds)

    if (IN(0)) { phase_prep(p, lds, gw, ngw, wave, lane); }
    SEAM(0);
    if (IN(1)) { pg8::Gemm g{XB, (const bf16_t*)(ws + WS_WIN), NROWS, NWIN, 1024}; pg8::StaticOrder S; S.init(NROWS, NWIN, G, bx); EpiH1 E{H1, GL};
        pg8::gemm_phase<EpiH1, pg8::StaticOrder, true, true>(LDSP, g, S, E); }
    SEAM(1);
    if (IN(2)) {
        for (int u = bx; u < 512; u += G) {
            if (u < 256) { const int b = u >> 3, h = (u >> 1) & 3, half = u & 1;
                gla_unit<64>(lds, H1, GL, OG, (size_t)b * SEQ, SEQ / 64, h, half, nullptr, p.out + OUT_SP + (size_t)(b * 4 + h) * 128 * 256, p.in[6], p.in[7]); }
            else { const int v = u - 256, b = v >> 3, h = (v >> 1) & 3, half = v & 1;
                gla_unit<16>(lds, H1, GL, OG, (size_t)NPROMPT + (size_t)b * DEC_SEQ, 1, h, half, p.in[2] + (size_t)(b * 4 + h) * 128 * 256, p.out + OUT_SS + (size_t)(b * 4 + h) * 128 * 256, p.in[6], p.in[7]); }
        }
    }
    SEAM(2);
    if (IN(3)) { phase_ognorm(OG, H1, p.in[8], gw, ngw, lane); }
    SEAM(3);
    if (IN(4)) { pg8::Gemm g{OG, (const bf16_t*)(ws + WS_WOA), NROWS, 1024, 1024}; pg8::StaticOrder S; S.init(NROWS, 1024, G, bx); EpiRes E{XR};
        pg8::gemm_phase<EpiRes, pg8::StaticOrder, true, true>(LDSP, g, S, E); }
    SEAM(4);
    if (IN(5)) { phase_ln(XR, XB, p.in[17], p.in[18], gw, ngw, lane); }
    SEAM(5);
    if (IN(6)) { pg8::Gemm g{XB, (const bf16_t*)(ws + WS_WUP0), NROWS, DFF, 1024}; pg8::StaticOrder S; S.init(NROWS, DFF, G, bx); EpiUp E{U};
        pg8::gemm_phase<EpiUp, pg8::StaticOrder, true, true>(LDSP, g, S, E); }
    SEAM(6);
    if (IN(7)) { pg8::Gemm g{U, (const bf16_t*)(ws + WS_WDN0), NROWS, 1024, DFF}; pg8::StaticOrder S; S.init(NROWS, 1024, G, bx); EpiRes E{XR};
        pg8::gemm_phase<EpiRes, pg8::StaticOrder, true, true>(LDSP, g, S, E); }
    SEAM(7);
    if (IN(8)) { phase_ln(XR, XB, p.in[17] + 1024, p.in[18] + 1024, gw, ngw, lane); }
    SEAM(8);
    if (IN(9)) { pg8::Gemm g{XB, (const bf16_t*)(ws + WS_WKVQ), NROWS, 3072, 1024}; pg8::StaticOrder S; S.init(NROWS, 3072, G, bx);
        EpiKVQ E{p.out, KB, VB, QB, KSb, VSb, (const float*)(ws + WS_ROPE)};
        pg8::gemm_phase<EpiKVQ, pg8::StaticOrder, true, true>(LDSP, g, S, E); }
    SEAM(9);
    if (IN(10)) {
        const float* lm = p.in[12];
        const float d1 = wave_sum(lm[lane] * lm[64 + lane]), d2 = wave_sum(lm[128 + lane] * lm[192 + lane]);
        const float lam = __expf(d1) - __expf(d2) + LAMBDA_INIT;
        for (int u = bx; u < 256; u += G) {
            const int b = u >> 3, h = u & 7;
            for (int i = 15; i >= 0; --i) {
                const size_t qrow = (size_t)b * SEQ + 128 * i;
                attn_unit(lds, QB + qrow * DM + h * 128, KB + (size_t)b * SEQ * DM + h * 128, VB + (size_t)b * SEQ * DM + h * 128, OB + qrow * DM + h * 128,
                          2 * i + 1, 2 * i + 2, 1 << 30, false, lam, p.in[13]);
            }
        }
        for (int u = bx; u < 256; u += G) {
            const int b = u >> 3, h = u & 7;
            const size_t qrow = (size_t)NPROMPT + (size_t)b * DEC_SEQ;
            attn_unit(lds, QB + qrow * DM + h * 128, KSb + (size_t)b * KVS_ROWS * DM + h * 128, VSb + (size_t)b * KVS_ROWS * DM + h * 128, OB + qrow * DM + h * 128,
                      17, 17, PAST + DEC_SEQ, true, lam, p.in[13]);
        }
    }
    SEAM(10);
    if (IN(11)) { pg8::Gemm g{OB, (const bf16_t*)(ws + WS_WOB), NROWS, 1024, 1024}; pg8::StaticOrder S; S.init(NROWS, 1024, G, bx); EpiRes E{XR};
        pg8::gemm_phase<EpiRes, pg8::StaticOrder, true, true>(LDSP, g, S, E); }
    SEAM(11);
    if (IN(12)) { phase_ln(XR, XB, p.in[17] + 2048, p.in[18] + 2048, gw, ngw, lane); }
    SEAM(12);
    if (IN(13)) { pg8::Gemm g{XB, (const bf16_t*)(ws + WS_WUP1), NROWS, DFF, 1024}; pg8::StaticOrder S; S.init(NROWS, DFF, G, bx); EpiUp E{U};
        pg8::gemm_phase<EpiUp, pg8::StaticOrder, true, true>(LDSP, g, S, E); }
    SEAM(13);
    if (IN(14)) { pg8::Gemm g{U, (const bf16_t*)(ws + WS_WDN1), NROWS, 1024, DFF}; pg8::StaticOrder S; S.init(NROWS, 1024, G, bx); EpiRes E{XR};
        pg8::gemm_phase<EpiRes, pg8::StaticOrder, true, true>(LDSP, g, S, E); }
    SEAM(14);
    if (IN(15)) { phase_ln(XR, nullptr, p.in[17] + 3072, p.in[18] + 3072, gw, ngw, lane); }
#undef IN
#undef SEAM
}

#ifndef ONE_LAUNCH
#define ONE_LAUNCH 1
#endif
extern "C" void kernel_launch(void* const* d_in, const int* in_sizes, int n_in, void* d_out, int out_size, void* d_ws, size_t ws_size, hipStream_t stream) {
    static int grid = 0;
    if (grid == 0) {
        if (n_in != 19 || ws_size < WS_END) { fprintf(stderr, "kernel_launch: unexpected n_in %d / ws_size %zu (need %zu)\n", n_in, ws_size, (size_t)WS_END); grid = -1; return; }
        int dev = 0, cus = 0, per_cu = 0;
        hipGetDevice(&dev); hipDeviceGetAttribute(&cus, hipDeviceAttributeMultiprocessorCount, dev);
        if (hipFuncSetAttribute((const void*)yoco_fwd, hipFuncAttributeMaxDynamicSharedMemorySize, LDS_BYTES) != hipSuccess) { fprintf(stderr, "kernel_launch: hipFuncSetAttribute failed\n"); grid = -1; return; }
        if (hipOccupancyMaxActiveBlocksPerMultiprocessor(&per_cu, (const void*)yoco_fwd, NTHREADS, LDS_BYTES) != hipSuccess || per_cu < 1) { fprintf(stderr, "kernel_launch: occupancy query says %d\n", per_cu); per_cu = 1; }
        (void)hipGetLastError();
        grid = cus * 1;
        if (grid <= 0) grid = 256;
    }
    if (grid < 0) return;
    Params p{};
    for (int i = 0; i < 19; ++i) p.in[i] = (const float*)d_in[i];
    p.out = (float*)d_out; p.ws = (unsigned char*)d_ws;
#if ONE_LAUNCH
    p.ph_lo = 0; p.ph_hi = NPHASE;
    void* args[] = {&p};
    hipError_t e = hipLaunchCooperativeKernel((const void*)yoco_fwd, dim3(grid), dim3(NTHREADS), args, LDS_BYTES, stream);
    if (e != hipSuccess) fprintf(stderr, "cooperative launch failed: %s (grid %d)\n", hipGetErrorString(e), grid);
#else
    for (int ph = 0; ph < NPHASE; ++ph) {
        p.ph_lo = ph; p.ph_hi = ph + 1;
        hipLaunchKernelGGL(yoco_fwd, dim3(grid), dim3(NTHREADS), LDS_BYTES, stream, p);
    }
#endif
}
```

```cpp
#include <hip/hip_runtime.h>
#include <hip/hip_cooperative_groups.h>
#include <cstdio>
#include <cstdint>
#include <cmath>
namespace cg = cooperative_groups;
namespace pg8 {
#define PG8_LAS __attribute__((address_space(3)))
typedef unsigned short bf16_t;
typedef short bf16x8 __attribute__((ext_vector_type(8)));
typedef float f32x4 __attribute__((ext_vector_type(4)));
typedef unsigned u32x4 __attribute__((ext_vector_type(4)));
constexpr int BM = 256, BK = 64, HALF = 128, HTB = HALF * BK * 2  , STAGE_BYTES = 8 * HTB, NXCD = 8, WGM = 8;

__host__ __device__ __forceinline__ int lds_byte(int r, int c) { const int st = (r >> 4) * 2 + (c >> 5), rr = r & 15, cc = c & 31, ob = rr * 64 + cc * 2; return st * 1024 + (ob ^ (((ob >> 9) & 1) << 5)); }
__host__ __device__ __forceinline__ void stage_rc(int b, int& R, int& C) { const int st = b / 1024, sb = b % 1024, swz = sb ^ (((sb >> 9) & 1) << 5); R = (st >> 1) * 16 + swz / 64; C = (st & 1) * 32 + (swz % 64) / 2; }
__host__ __device__ __forceinline__ int perm32(int rho) { const int n = rho >> 4, i = rho & 15; return 8 * (i >> 2) + 4 * n + (i & 3); }

struct Unit { int pm, pn; };
struct Gemm { const bf16_t* A; const bf16_t* Bt; int M, N, K; };

struct StaticOrder {
    int nM, nN, nwg, G, c;
    __host__ __device__ void init(int M, int N, int G_, int c_) { nM = M / BM; nN = N / BM; nwg = nM * nN; G = G_; c = c_; }
    __host__ __device__ bool next(int i, Unit& u) const {
        const long L = (long)i * G + c; if (L >= nwg) return false;
        int wgid = (int)L; { const int q = nwg / NXCD, r = nwg % NXCD, xcd = wgid % NXCD, off = wgid / NXCD; wgid = (xcd < r ? xcd * (q + 1) : r * (q + 1) + (xcd - r) * q) + off; }
        const int nig = WGM * nN, gid = wgid / nig, fm = gid * WGM, gsz = (nM - fm) < WGM ? (nM - fm) : WGM;
        u.pm = fm + ((wgid % nig) % gsz); u.pn = (wgid % nig) / gsz; return true;
    }
    __device__ __forceinline__ void a_ready(const Unit&) const {}
    __device__ __forceinline__ void done(const Unit&) const {}
};

typedef float f32x2 __attribute__((ext_vector_type(2)));
template <class Epi, class Sched, bool ALIGN_EPI = false, bool SP2 = false>
__device__ __forceinline__ void gemm_phase(PG8_LAS unsigned char* lds, const Gemm g, const Sched& S, const Epi& E) {
    const int tid = threadIdx.x, wid = __builtin_amdgcn_readfirstlane(tid >> 6), lane = tid & 63, wr = wid >> 2, wc = wid & 3, fr = lane & 15, fq = lane >> 4;
    const int K = g.K, nt = K / BK;
    unsigned voffA[2], voffB[2];
#pragma unroll
    for (int i = 0; i < 2; ++i) { int R, C; stage_rc(tid * 16 + i * 8192, R, C); const int Rb = Epi::PERM ? ((R & ~31) + perm32(R & 31)) : R;
        voffA[i] = (unsigned)(R * K + C) * 2u; voffB[i] = (unsigned)(Rb * K + C) * 2u; }
    const size_t kstep = (size_t)(BK * 2);
    const size_t hstep = (size_t)HALF * K * 2;
    const size_t tstep = 2 * hstep;
    const unsigned ldsw = (unsigned)wid * 1024u;
    const int aoff = lds_byte(wr * 64 + fr, fq * 8), boff = lds_byte(wc * 32 + fr, fq * 8);
#define PG8_SA(b, h) (((b) * 2 + (h)) * HTB)
#define PG8_SB(b, h) ((4 + (b) * 2 + (h)) * HTB)
#define PG8_STAGE(bufoff, gbase, voff) do { _Pragma("unroll") for (int _i = 0; _i < 2; ++_i) \
        __builtin_amdgcn_global_load_lds((const unsigned*)((const char*)(gbase) + (voff)[_i]), (PG8_LAS unsigned*)(lds + (bufoff) + ldsw + _i * 8192), 16, 0, 0); } while (0)
#define PG8_LDA(dst, b, h) do { _Pragma("unroll") for (int m = 0; m < 4; ++m) _Pragma("unroll") for (int k = 0; k < 2; ++k) dst[m][k] = *(const PG8_LAS bf16x8*)(lds + PG8_SA(b, h) + aoff + m * 2048 + k * 1024); } while (0)
#define PG8_LDB(dst, b, h) do { _Pragma("unroll") for (int n = 0; n < 2; ++n) _Pragma("unroll") for (int k = 0; k < 2; ++k) dst[n][k] = *(const PG8_LAS bf16x8*)(lds + PG8_SB(b, h) + boff + n * 2048 + k * 1024); } while (0)
#define PG8_MMA(ai, bj, At, Bt) do { __builtin_amdgcn_s_setprio(1); _Pragma("unroll") for (int m = 0; m < 4; ++m) _Pragma("unroll") for (int n = 0; n < 2; ++n) _Pragma("unroll") for (int k = 0; k < 2; ++k) \
        acc[ai][bj][m][n] = __builtin_amdgcn_mfma_f32_16x16x32_bf16(Bt[n][k], At[m][k], acc[ai][bj][m][n], 0, 0, 0); __builtin_amdgcn_s_setprio(0); } while (0)
#define PG8_WAIT_V(n) asm volatile("s_waitcnt vmcnt(" #n ")" ::: "memory")
#define PG8_WAIT_L(n) asm volatile("s_waitcnt lgkmcnt(" #n ")" ::: "memory")
#define PG8_BAR __builtin_amdgcn_s_barrier()
#define PG8_SCHED __builtin_amdgcn_sched_barrier(0)
    Unit cur, nxt; int ui = 0;
    if (!S.next(0, cur)) return;
    f32x4 acc[2][2][4][2];
#pragma unroll
    for (int a = 0; a < 2; ++a)
#pragma unroll
        for (int b = 0; b < 2; ++b)
#pragma unroll
            for (int m = 0; m < 4; ++m)
#pragma unroll
                for (int n = 0; n < 2; ++n) acc[a][b][m][n] = (f32x4){0.f, 0.f, 0.f, 0.f};
    bf16x8 At[4][2], B0[2][2], B1[2][2];
    const char* cA = (const char*)g.A + (size_t)cur.pm * tstep; const char* cB = (const char*)g.Bt + (size_t)cur.pn * tstep;
    S.a_ready(cur);
    if constexpr (SP2) {
        PG8_STAGE(PG8_SB(0, 0), cB, voffB); PG8_STAGE(PG8_SB(0, 1), cB + hstep, voffB); PG8_STAGE(PG8_SA(0, 0), cA, voffA); PG8_STAGE(PG8_SA(0, 1), cA + hstep, voffA);
        if (wr == 1) PG8_BAR;
        PG8_WAIT_V(2); PG8_BAR;
        PG8_STAGE(PG8_SB(1, 0), cB + kstep, voffB); PG8_STAGE(PG8_SA(1, 0), cA + kstep, voffA); PG8_STAGE(PG8_SB(1, 1), cB + hstep + kstep, voffB);
        PG8_WAIT_V(6); PG8_BAR;
    } else {
        PG8_STAGE(PG8_SB(0, 0), cB, voffB); PG8_STAGE(PG8_SA(0, 0), cA, voffA); PG8_STAGE(PG8_SB(0, 1), cB + hstep, voffB); PG8_STAGE(PG8_SA(0, 1), cA + hstep, voffA);
        if (wr == 1) PG8_BAR;
        PG8_WAIT_V(4); PG8_BAR;
        PG8_STAGE(PG8_SB(1, 0), cB + kstep, voffB); PG8_STAGE(PG8_SA(1, 0), cA + kstep, voffA); PG8_STAGE(PG8_SB(1, 1), cB + hstep + kstep, voffB);
        PG8_WAIT_V(6); PG8_BAR;
    }
    for (;;) {
        const bool has_next = S.next(ui + 1, nxt);
        const char* nA = has_next ? (const char*)g.A + (size_t)nxt.pm * tstep : cA; const char* nB = has_next ? (const char*)g.Bt + (size_t)nxt.pn * tstep : cB;
        for (int t = 0; t < nt; t += 2) {
            const bool last = (t == nt - 2);
            const char* a1 = cA + (size_t)(t + 1) * kstep;
            const char* a2 = last ? nA : cA + (size_t)(t + 2) * kstep; const char* b2 = last ? nB : cB + (size_t)(t + 2) * kstep;
            const char* a3 = a2 + kstep; const char* b3 = b2 + kstep;
            if (last && has_next) S.a_ready(nxt);
            if constexpr (SP2) {
            PG8_LDB(B0, 0, 0); PG8_LDB(B1, 0, 1); PG8_SCHED; PG8_LDA(At, 0, 0); PG8_STAGE(PG8_SA(1, 1), a1 + hstep, voffA);
            PG8_WAIT_V(8); PG8_WAIT_L(0); PG8_BAR; PG8_MMA(0, 0, At, B0); PG8_MMA(0, 1, At, B1); PG8_BAR; PG8_SCHED;
            PG8_LDA(At, 0, 1); PG8_STAGE(PG8_SB(0, 0), b2, voffB); PG8_STAGE(PG8_SB(0, 1), b2 + hstep, voffB); PG8_STAGE(PG8_SA(0, 0), a2, voffA);
            PG8_WAIT_V(8); PG8_WAIT_L(0); PG8_BAR; PG8_MMA(1, 0, At, B0); PG8_MMA(1, 1, At, B1); PG8_BAR; PG8_SCHED;
            PG8_LDB(B0, 1, 0); PG8_LDB(B1, 1, 1); PG8_SCHED; PG8_LDA(At, 1, 0); PG8_STAGE(PG8_SA(0, 1), a2 + hstep, voffA);
            PG8_WAIT_V(8); PG8_WAIT_L(0); PG8_BAR; PG8_MMA(0, 0, At, B0); PG8_MMA(0, 1, At, B1); PG8_BAR; PG8_SCHED;
            PG8_LDA(At, 1, 1); PG8_STAGE(PG8_SB(1, 0), b3, voffB); PG8_STAGE(PG8_SB(1, 1), b3 + hstep, voffB); PG8_STAGE(PG8_SA(1, 0), a3, voffA);
            PG8_WAIT_V(8); PG8_WAIT_L(0); PG8_BAR; PG8_MMA(1, 0, At, B0); PG8_MMA(1, 1, At, B1); PG8_BAR; PG8_SCHED;
            } else {
            PG8_LDB(B0, 0, 0); PG8_SCHED; PG8_LDA(At, 0, 0); PG8_STAGE(PG8_SA(1, 1), a1 + hstep, voffA);
            PG8_WAIT_L(8); PG8_BAR; PG8_WAIT_L(0); PG8_MMA(0, 0, At, B0); PG8_BAR; PG8_SCHED;
            PG8_LDB(B1, 0, 1); PG8_STAGE(PG8_SB(0, 0), b2, voffB);
            PG8_BAR; PG8_WAIT_L(0); PG8_MMA(0, 1, At, B1); PG8_BAR;
            PG8_LDA(At, 0, 1); PG8_STAGE(PG8_SA(0, 0), a2, voffA);
            PG8_BAR; PG8_WAIT_L(0); PG8_MMA(1, 0, At, B0); PG8_BAR; PG8_SCHED;
            PG8_STAGE(PG8_SB(0, 1), b2 + hstep, voffB);
            PG8_WAIT_V(6); PG8_BAR; PG8_MMA(1, 1, At, B1); PG8_BAR;
            PG8_LDB(B0, 1, 0); PG8_SCHED; PG8_LDA(At, 1, 0); PG8_STAGE(PG8_SA(0, 1), a2 + hstep, voffA);
            PG8_WAIT_L(8); PG8_BAR; PG8_WAIT_L(0); PG8_MMA(0, 0, At, B0); PG8_BAR; PG8_SCHED;
            PG8_LDB(B1, 1, 1); PG8_STAGE(PG8_SB(1, 0), b3, voffB);
            PG8_BAR; PG8_WAIT_L(0); PG8_MMA(0, 1, At, B1); PG8_BAR;
            PG8_LDA(At, 1, 1); PG8_STAGE(PG8_SA(1, 0), a3, voffA);
            PG8_BAR; PG8_WAIT_L(0); PG8_MMA(1, 0, At, B0); PG8_BAR; PG8_SCHED;
            PG8_STAGE(PG8_SB(1, 1), b3 + hstep, voffB);
            PG8_WAIT_V(6); PG8_BAR; PG8_MMA(1, 1, At, B1); PG8_BAR;
            }
        }
        if constexpr (ALIGN_EPI) { if (wr == 0) PG8_BAR; }
        if constexpr (!Epi::AFTER_DRAIN) { E(acc, cur, wr, wc, fr, fq); S.done(cur); }
        if (!has_next) break;
#pragma unroll
        for (int a = 0; a < 2; ++a)
#pragma unroll
            for (int b = 0; b < 2; ++b)
#pragma unroll
                for (int m = 0; m < 4; ++m)
#pragma unroll
                    for (int n = 0; n < 2; ++n) acc[a][b][m][n] = (f32x4){0.f, 0.f, 0.f, 0.f};
        cur = nxt; cA = nA; cB = nB; ++ui;
        if constexpr (ALIGN_EPI) { if (wr == 1) PG8_BAR; }
    }
    PG8_WAIT_V(0);
    if constexpr (!ALIGN_EPI) { if (wr == 0) PG8_BAR; }
    PG8_BAR;
    if constexpr (Epi::AFTER_DRAIN) { E.fused(acc, cur, wr, wc, fr, fq, lds, wid, lane); S.done(cur); }
#undef PG8_SA
#undef PG8_SB
#undef PG8_STAGE
#undef PG8_LDA
#undef PG8_LDB
#undef PG8_MMA
#undef PG8_WAIT_V
#undef PG8_WAIT_L
#undef PG8_BAR
#undef PG8_SCHED
}
}

typedef unsigned short bf16_t;
typedef short bf16x8 __attribute__((ext_vector_type(8)));
typedef short s16x4 __attribute__((ext_vector_type(4)));
typedef float f32x4 __attribute__((ext_vector_type(4)));
typedef float f32x2v __attribute__((ext_vector_type(2)));
typedef __bf16 bf16x2_t __attribute__((ext_vector_type(2)));
typedef unsigned u32x4 __attribute__((ext_vector_type(4)));
typedef unsigned u32x2 __attribute__((ext_vector_type(2)));

constexpr int DM = 1024;
constexpr int NPROMPT = 32 * 2048;
constexpr int NSAMPLE = 32 * 16;
constexpr int NROWS = NPROMPT + NSAMPLE;
constexpr int SEQ = 2048, DEC_SEQ = 16, PAST = 1024, KVS_ROWS = 1088;
constexpr int H1W = 3072;
constexpr int NWIN = 3328;
constexpr int DFF = 4096;
constexpr float ALPHA = 1.4142135623730951f;
constexpr float LAMBDA_INIT = 0.35550906759096934f;
constexpr float LN_EPS = 1e-5f, RMS_EPS = 1e-5f;
constexpr float QSCALE_B = 0.18033688011112042f;
constexpr float QSCALE_A = 0.08838834764831845f;

constexpr size_t MiB = 1u << 20;
constexpr size_t WS_WIN = 0, WS_WOA = 7 * MiB, WS_WKVQ = 9 * MiB, WS_WOB = 15 * MiB, WS_WUP0 = 17 * MiB, WS_WUP1 = 25 * MiB,
                 WS_WDN0 = 33 * MiB, WS_WDN1 = 41 * MiB, WS_ROPE = 49 * MiB, WS_GL = 50 * MiB, WS_XB = 56 * MiB,
                 WS_KS = 186 * MiB, WS_VS = 254 * MiB, WS_BIG = 322 * MiB;
constexpr size_t BIG_H1 = 0, BIG_OG = (size_t)NROWS * H1W * 2, BIG_U = 0, BIG_KB = 0, BIG_VB = 128 * MiB, BIG_QB = 256 * MiB, BIG_OB = 385 * MiB;
constexpr size_t WS_END = WS_BIG + 516 * MiB;
static_assert(BIG_OG + (size_t)NROWS * DM * 2 <= 516 * MiB, "big region");
static_assert(BIG_OB + (size_t)NROWS * DM * 2 <= 516 * MiB, "big region");
static_assert((size_t)NROWS * DFF * 2 <= 516 * MiB, "big region");

constexpr size_t OUT_Y = 0, OUT_SP = 67633152, OUT_KP = 71827456, OUT_VP = 138936320, OUT_SS = 206045184, OUT_KSMP = 210239488, OUT_VSMP = 210763776;

constexpr int NTHREADS = 512, NWAVES = 8;
constexpr int LDS_BYTES = 147456;

#define DI __device__ __forceinline__
DI unsigned cvtpk(float lo, float hi) { f32x2v v = {lo, hi}; bf16x2_t b = __builtin_convertvector(v, bf16x2_t); return __builtin_bit_cast(unsigned, b); }
DI float bf2f(unsigned short h) { return __uint_as_float(((unsigned)h) << 16); }
DI float bflo(unsigned w) { return __uint_as_float(w << 16); }
DI float bfhi(unsigned w) { return __uint_as_float(w & 0xffff0000u); }
DI bf16x8 pack8(f32x4 a, f32x4 b) { u32x4 p; p.x = cvtpk(a[0], a[1]); p.y = cvtpk(a[2], a[3]); p.z = cvtpk(b[0], b[1]); p.w = cvtpk(b[2], b[3]); return __builtin_bit_cast(bf16x8, p); }
#define MFMA16(a, b, c) __builtin_amdgcn_mfma_f32_16x16x32_bf16((a), (b), (c), 0, 0, 0)

struct Params { const float* in[19]; float* out; unsigned char* ws; int ph_lo, ph_hi; };

struct EpiH1 {
    static constexpr bool PERM = true, AFTER_DRAIN = false;
    bf16_t* H1; float* GL;
    DI void operator()(const pg8::f32x4 (&acc)[2][2][4][2], const pg8::Unit& u, int wr, int wc, int fr, int fq) const {
        const int row0 = u.pm * 256 + wr * 64 + fr;
        if (u.pn < 12) {
            const float sc = (u.pn < 2) ? QSCALE_A : 1.0f;
            const int col0 = u.pn * 256 + wc * 32 + 8 * fq;
#pragma unroll
            for (int ai = 0; ai < 2; ++ai)
#pragma unroll
                for (int m = 0; m < 4; ++m) { bf16_t* rowp = H1 + (size_t)(row0 + ai * 128 + m * 16) * H1W + col0;
#pragma unroll
                    for (int bj = 0; bj < 2; ++bj) { f32x4 v0 = acc[ai][bj][m][0] * sc, v1 = acc[ai][bj][m][1] * sc; u32x4 w;
                        w.x = cvtpk(v0[0], v0[1]); w.y = cvtpk(v0[2], v0[3]); w.z = cvtpk(v1[0], v1[1]); w.w = cvtpk(v1[2], v1[3]);
                        *(u32x4*)(rowp + bj * 128) = w; } }
        } else {
            if (wc == 0 && fq < 2) {
#pragma unroll
                for (int ai = 0; ai < 2; ++ai)
#pragma unroll
                    for (int m = 0; m < 4; ++m) { float* rowp = GL + (size_t)(row0 + ai * 128 + m * 16) * 16 + 8 * fq;
                        *(f32x4*)(rowp) = acc[ai][0][m][0]; *(f32x4*)(rowp + 4) = acc[ai][0][m][1]; }
            }
        }
    }
};
struct EpiRes {
    static constexpr bool PERM = false, AFTER_DRAIN = false;
    float* XR;
    DI void operator()(const pg8::f32x4 (&acc)[2][2][4][2], const pg8::Unit& u, int wr, int wc, int fr, int fq) const {
        const int row0 = u.pm * 256 + wr * 64 + fr, col0 = u.pn * 256 + wc * 32 + 4 * fq;
#pragma unroll
        for (int ai = 0; ai < 2; ++ai)
#pragma unroll
            for (int m = 0; m < 4; ++m) { float* rowp = XR + (size_t)(row0 + ai * 128 + m * 16) * DM + col0;
#pragma unroll
                for (int bj = 0; bj < 2; ++bj)
#pragma unroll
                    for (int n = 0; n < 2; ++n) { float* p = rowp + bj * 128 + n * 16; const f32x4 b = *(const f32x4*)p; *(f32x4*)p = b * ALPHA + acc[ai][bj][m][n]; } }
    }
};
struct EpiUp {
    static constexpr bool PERM = true, AFTER_DRAIN = false;
    bf16_t* U;
    DI void operator()(const pg8::f32x4 (&acc)[2][2][4][2], const pg8::Unit& u, int wr, int wc, int fr, int fq) const {
        const int row0 = u.pm * 256 + wr * 64 + fr, col0 = u.pn * 256 + wc * 32 + 8 * fq;
#pragma unroll
        for (int ai = 0; ai < 2; ++ai)
#pragma unroll
            for (int m = 0; m < 4; ++m) { bf16_t* rowp = U + (size_t)(row0 + ai * 128 + m * 16) * DFF + col0;
#pragma unroll
                for (int bj = 0; bj < 2; ++bj) { f32x4 v0 = acc[ai][bj][m][0], v1 = acc[ai][bj][m][1];
#pragma unroll
                    for (int i = 0; i < 4; ++i) { float a = fmaxf(v0[i], 0.f), b = fmaxf(v1[i], 0.f); v0[i] = a * a; v1[i] = b * b; }
                    u32x4 w; w.x = cvtpk(v0[0], v0[1]); w.y = cvtpk(v0[2], v0[3]); w.z = cvtpk(v1[0], v1[1]); w.w = cvtpk(v1[2], v1[3]);
                    *(u32x4*)(rowp + bj * 128) = w; } }
    }
};
struct EpiKVQ {
    static constexpr bool PERM = false, AFTER_DRAIN = false;
    float* out; bf16_t *KB, *VB, *QB, *KS, *VS; const float* rope;
    DI void operator()(const pg8::f32x4 (&acc)[2][2][4][2], const pg8::Unit& u, int wr, int wc, int fr, int fq) const {
        const int kind = u.pn >> 2;
        const int colt = (u.pn & 3) * 256 + wc * 32 + 4 * fq;
        const bool do_rope = (kind != 1) && ((wc & 1) == 0);
#pragma unroll
        for (int ai = 0; ai < 2; ++ai)
#pragma unroll
            for (int m = 0; m < 4; ++m) {
                const int row = u.pm * 256 + wr * 64 + fr + ai * 128 + m * 16;
                const bool smp = row >= NPROMPT; const int rs = row - NPROMPT;
                const int pos = smp ? (PAST + (rs & 15)) : (row & (SEQ - 1));
                float* of; bf16_t* ob;
                if (kind == 0) { of = smp ? out + OUT_KSMP + (size_t)rs * DM : out + OUT_KP + (size_t)row * DM;
                                 ob = smp ? KS + ((size_t)(rs >> 4) * KVS_ROWS + PAST + (rs & 15)) * DM : KB + (size_t)row * DM; }
                else if (kind == 1) { of = smp ? out + OUT_VSMP + (size_t)rs * DM : out + OUT_VP + (size_t)row * DM;
                                 ob = smp ? VS + ((size_t)(rs >> 4) * KVS_ROWS + PAST + (rs & 15)) * DM : VB + (size_t)row * DM; }
                else { of = nullptr; ob = QB + (size_t)row * DM; }
#pragma unroll
                for (int bj = 0; bj < 2; ++bj)
#pragma unroll
                    for (int n = 0; n < 2; ++n) {
                        f32x4 v = acc[ai][bj][m][n];
                        if (n == 0 && do_rope) {
                            f32x4 pr; pr[0] = __shfl_xor(v[0], 32); pr[1] = __shfl_xor(v[1], 32); pr[2] = __shfl_xor(v[2], 32); pr[3] = __shfl_xor(v[3], 32);
                            const float* rp = rope + (size_t)pos * 16 + 8 * (fq & 1);
                            const f32x4 cs0 = *(const f32x4*)rp, cs1 = *(const f32x4*)(rp + 4);
                            const float sg = (fq < 2) ? -1.f : 1.f;
                            v[0] = v[0] * cs0[0] + sg * pr[0] * cs0[1]; v[1] = v[1] * cs0[2] + sg * pr[1] * cs0[3];
                            v[2] = v[2] * cs1[0] + sg * pr[2] * cs1[1]; v[3] = v[3] * cs1[2] + sg * pr[3] * cs1[3];
                        }
                        const int col = colt + bj * 128 + n * 16;
                        if (kind == 2) v = v * QSCALE_B; else *(f32x4*)(of + col) = v;
                        u32x2 w; w.x = cvtpk(v[0], v[1]); w.y = cvtpk(v[2], v[3]); *(u32x2*)(ob + col) = w;
                    }
            }
    }
};

DI float wave_sum(float v) {
#pragma unroll
    for (int o = 1; o < 64; o <<= 1) v += __shfl_xor(v, o);
    return v;
}
DI void transpose_item(const float* W, int ldw, int col0, int K, int ncols, bf16_t* WT, int row_off, float* scr, int item, int lane) {
    const int nblk = ncols / 32, kb = item / nblk, nb = item % nblk, k0 = 64 * kb, n0 = 32 * nb;
#pragma unroll 8
    for (int i = 0; i < 32; ++i) { const int kk = 2 * i + (lane >> 5); scr[kk * 33 + (lane & 31)] = W[(size_t)(k0 + kk) * ldw + col0 + n0 + (lane & 31)]; }
    asm volatile("s_waitcnt lgkmcnt(0)" ::: "memory");
    const int c = lane & 7;
#pragma unroll
    for (int j = 0; j < 4; ++j) { const int n = (lane >> 3) + 8 * j; const float* s = scr + (8 * c) * 33 + n;
        u32x4 o; o.x = cvtpk(s[0 * 33], s[1 * 33]); o.y = cvtpk(s[2 * 33], s[3 * 33]); o.z = cvtpk(s[4 * 33], s[5 * 33]); o.w = cvtpk(s[6 * 33], s[7 * 33]);
        *(u32x4*)(WT + (size_t)(row_off + n0 + n) * K + k0 + 8 * c) = o; }
    asm volatile("s_waitcnt lgkmcnt(0)" ::: "memory");
}
DI void cvt_row(const float* src, bf16_t* dstb, float* dstf, int lane) {
    const f32x4* s = (const f32x4*)src + lane;
    f32x4 v[4];
#pragma unroll
    for (int j = 0; j < 4; ++j) v[j] = s[64 * j];
    u32x2* o = (u32x2*)dstb + lane;
#pragma unroll
    for (int j = 0; j < 4; ++j) { u32x2 w; w.x = cvtpk(v[j][0], v[j][1]); w.y = cvtpk(v[j][2], v[j][3]); o[64 * j] = w; }
    if (dstf) { f32x4* f = (f32x4*)dstf + lane;
#pragma unroll
        for (int j = 0; j < 4; ++j) f[64 * j] = v[j]; }
}

DI void phase_prep(const Params& p, unsigned char* lds, int gw, int ngw, int wave, int lane) {
    unsigned char* ws = p.ws;
    float* scr = (float*)(lds + wave * 16384);
    constexpr int I_IN = 16 * 96, I_SQ = 16 * 32, I_KV = 16 * 64, I_UP = 16 * 128, I_DN = 64 * 32;
    constexpr int NIT = I_IN + I_SQ + I_KV + I_SQ + I_SQ + 2 * I_UP + 2 * I_DN;
    for (int it = gw; it < NIT; it += ngw) {
        int r = it;
        if (r < I_IN) { transpose_item(p.in[5], 3088, 0, 1024, 3072, (bf16_t*)(ws + WS_WIN), 0, scr, r, lane); continue; } r -= I_IN;
        if (r < I_SQ) { transpose_item(p.in[9], 1024, 0, 1024, 1024, (bf16_t*)(ws + WS_WOA), 0, scr, r, lane); continue; } r -= I_SQ;
        if (r < I_KV) { transpose_item(p.in[10], 2048, 0, 1024, 2048, (bf16_t*)(ws + WS_WKVQ), 0, scr, r, lane); continue; } r -= I_KV;
        if (r < I_SQ) { transpose_item(p.in[11], 1024, 0, 1024, 1024, (bf16_t*)(ws + WS_WKVQ), 2048, scr, r, lane); continue; } r -= I_SQ;
        if (r < I_SQ) { transpose_item(p.in[14], 1024, 0, 1024, 1024, (bf16_t*)(ws + WS_WOB), 0, scr, r, lane); continue; } r -= I_SQ;
        if (r < I_UP) { transpose_item(p.in[15], 4096, 0, 1024, 4096, (bf16_t*)(ws + WS_WUP0), 0, scr, r, lane); continue; } r -= I_UP;
        if (r < I_UP) { transpose_item(p.in[15] + (size_t)1024 * 4096, 4096, 0, 1024, 4096, (bf16_t*)(ws + WS_WUP1), 0, scr, r, lane); continue; } r -= I_UP;
        if (r < I_DN) { transpose_item(p.in[16], 1024, 0, 4096, 1024, (bf16_t*)(ws + WS_WDN0), 0, scr, r, lane); continue; } r -= I_DN;
        transpose_item(p.in[16] + (size_t)4096 * 1024, 1024, 0, 4096, 1024, (bf16_t*)(ws + WS_WDN1), 0, scr, r, lane);
    }
    for (int rr = gw; rr < 256; rr += ngw) {
        bf16_t* dst = (bf16_t*)(ws + WS_WIN) + (size_t)(3072 + rr) * 1024;
        for (int k = lane; k < 1024; k += 64) { const float v = (rr < 16) ? p.in[5][(size_t)k * 3088 + 3072 + rr] : 0.f; dst[k] = (bf16_t)(cvtpk(v, 0.f) & 0xffffu); }
    }
    for (int r = gw; r < NROWS; r += ngw) {
        const float* src = (r < NPROMPT) ? p.in[0] + (size_t)r * DM : p.in[1] + (size_t)(r - NPROMPT) * DM;
        cvt_row(src, (bf16_t*)(ws + WS_XB) + (size_t)r * DM, p.out + (size_t)r * DM, lane);
    }
    for (int r = gw; r < 2 * 32 * KVS_ROWS; r += ngw) {
        const int which = r / (32 * KVS_ROWS), rr = r % (32 * KVS_ROWS), b = rr / KVS_ROWS, t = rr % KVS_ROWS;
        bf16_t* dst = (bf16_t*)(ws + (which ? WS_VS : WS_KS)) + (size_t)rr * DM;
        if (t < PAST) cvt_row(p.in[which ? 4 : 3] + ((size_t)b * PAST + t) * DM, dst, nullptr, lane);
        else if (t >= PAST + DEC_SEQ) { u32x4 z = {0u, 0u, 0u, 0u}; ((u32x4*)dst)[lane] = z; ((u32x4*)dst)[lane + 64] = z; }
    }
    {
        const double invrev[8] = {0.15915494309189535, 0.03086376340470123, 0.005985185712713705, 0.0011606636412400608,
                                  0.00022507907903927653, 4.364795279280289e-05, 8.464330808241401e-06, 1.6414262627950345e-06};
        float* tab = (float*)(ws + WS_ROPE);
        for (int idx = gw * 64 + lane; idx < 2048 * 8; idx += ngw * 64) {
            const int pos = idx >> 3, i = idx & 7;
            double iv = invrev[0];
#pragma unroll
            for (int q = 1; q < 8; ++q) iv = (i == q) ? invrev[q] : iv;
            const double rev = (double)pos * iv; const float fr = (float)(rev - rint(rev));
            tab[2 * idx] = __builtin_amdgcn_cosf(fr); tab[2 * idx + 1] = __builtin_amdgcn_sinf(fr);
        }
    }
}

DI void phase_ln(float* XR, bf16_t* XB, const float* g, const float* b, int gw, int ngw, int lane) {
    f32x4 gv[4], bv[4];
#pragma unroll
    for (int j = 0; j < 4; ++j) { gv[j] = ((const f32x4*)g)[lane + 64 * j]; bv[j] = ((const f32x4*)b)[lane + 64 * j]; }
    for (int r = gw; r < NROWS; r += ngw) {
        f32x4* xr = (f32x4*)(XR + (size_t)r * DM) + lane;
        f32x4 v[4]; float s = 0.f;
#pragma unroll
        for (int j = 0; j < 4; ++j) { v[j] = xr[64 * j]; s += (v[j][0] + v[j][1]) + (v[j][2] + v[j][3]); }
        const float mean = wave_sum(s) * (1.f / DM); float s2 = 0.f;
#pragma unroll
        for (int j = 0; j < 4; ++j) { v[j] = v[j] - mean; s2 += (v[j][0] * v[j][0] + v[j][1] * v[j][1]) + (v[j][2] * v[j][2] + v[j][3] * v[j][3]); }
        const float rstd = 1.f / sqrtf(wave_sum(s2) * (1.f / DM) + LN_EPS);
#pragma unroll
        for (int j = 0; j < 4; ++j) { v[j] = v[j] * rstd * gv[j] + bv[j]; xr[64 * j] = v[j]; }
        if (XB) { u32x2* o = (u32x2*)(XB + (size_t)r * DM) + lane;
#pragma unroll
            for (int j = 0; j < 4; ++j) { u32x2 w; w.x = cvtpk(v[j][0], v[j][1]); w.y = cvtpk(v[j][2], v[j][3]); o[64 * j] = w; } }
    }
}

DI void phase_ognorm(bf16_t* OG, const bf16_t* H1, const float* gn, int gw, int ngw, int lane) {
    float g[16];
#pragma unroll
    for (int j = 0; j < 4; ++j) { const f32x4 t = *(const f32x4*)(gn + (16 * lane) % 256 + 4 * j); g[4 * j] = t[0]; g[4 * j + 1] = t[1]; g[4 * j + 2] = t[2]; g[4 * j + 3] = t[3]; }
    for (int r = gw; r < NROWS; r += ngw) {
        u32x4* op = (u32x4*)(OG + (size_t)r * DM + 16 * lane);
        const u32x4* rp = (const u32x4*)(H1 + (size_t)r * H1W + 2048 + 16 * lane);
        const u32x4 o0 = op[0], o1 = op[1], r0 = rp[0], r1 = rp[1];
        float o[16], rr[16];
#pragma unroll
        for (int j = 0; j < 4; ++j) { o[2 * j] = bflo(o0[j]); o[2 * j + 1] = bfhi(o0[j]); o[8 + 2 * j] = bflo(o1[j]); o[8 + 2 * j + 1] = bfhi(o1[j]);
            rr[2 * j] = bflo(r0[j]); rr[2 * j + 1] = bfhi(r0[j]); rr[8 + 2 * j] = bflo(r1[j]); rr[8 + 2 * j + 1] = bfhi(r1[j]); }
        float ss = 0.f;
#pragma unroll
        for (int j = 0; j < 16; ++j) ss += o[j] * o[j];
        ss += __shfl_xor(ss, 1); ss += __shfl_xor(ss, 2); ss += __shfl_xor(ss, 4); ss += __shfl_xor(ss, 8);
        const float rstd = 1.f / sqrtf(ss * (1.f / 256.f) + RMS_EPS);
#pragma unroll
        for (int j = 0; j < 16; ++j) { const float x = rr[j]; o[j] = o[j] * rstd * g[j] * (x / (1.f + __expf(-x))); }
        u32x4 w0, w1;
#pragma unroll
        for (int j = 0; j < 4; ++j) { w0[j] = cvtpk(o[2 * j], o[2 * j + 1]); w1[j] = cvtpk(o[8 + 2 * j], o[8 + 2 * j + 1]); }
        op[0] = w0; op[1] = w1;
    }
}

template <int C>
DI void gla_unit(unsigned char* lds, const bf16_t* H1, const float* GL, bf16_t* OG, size_t row0, int nchunks, int h, int half,
                 const float* S_init, float* S_out, const float* Wg, const float* bg) {
    constexpr int CP = (C < 32) ? 32 : C, PT = CP + 8, TPG = C / 4, QP = 136;
    const int tid = threadIdx.x, lane = tid & 63, w = __builtin_amdgcn_readfirstlane(tid >> 6), fr = lane & 15, fq = lane >> 4;
    float* GLS = (float*)(lds);
    float* TOT = (float*)(lds + 4096);
    float* DEC = (float*)(lds + 6144);
    bf16_t* VT = (bf16_t*)(lds + 8192);
    bf16_t* KT = (bf16_t*)(lds + 26624);
    bf16_t* QF = (bf16_t*)(lds + 45056);
    bf16_t* KF = (bf16_t*)(lds + 62464);
    bf16_t* ATT = (bf16_t*)(lds + 79872);
    __syncthreads();
    if (C < 32) { for (int i = tid; i < (89088 - 8192) / 16; i += NTHREADS) ((u32x4*)(lds + 8192))[i] = (u32x4){0u, 0u, 0u, 0u}; __syncthreads(); }
    const int dk = tid & 127, g = tid >> 7;
    float wg[16];
#pragma unroll
    for (int r = 0; r < 16; ++r) wg[r] = Wg[r * 512 + h * 128 + dk];
    const float bgv = bg[h * 128 + dk];
    const int vcol = half * 128 + 16 * w + fr;
    f32x4 S[8];
#pragma unroll
    for (int t = 0; t < 8; ++t)
#pragma unroll
        for (int r = 0; r < 4; ++r) S[t][r] = S_init ? S_init[(size_t)(16 * t + 4 * fq + r) * 256 + vcol] : 0.f;

    for (int ch = 0; ch < nchunks; ++ch) {
        const size_t rbase = row0 + (size_t)ch * C;
        if (tid < C * 4) ((f32x4*)GLS)[tid] = ((const f32x4*)(GL + rbase * 16))[tid];
#pragma unroll
        for (int it = 0; it < (C * 16 + NTHREADS - 1) / NTHREADS; ++it) {
            const int item = tid + NTHREADS * it;
            if (item < C * 16) {
                const int cc = item / C, j = item % C;
                const u32x4 v = *(const u32x4*)(H1 + (rbase + j) * H1W + 1024 + h * 256 + half * 128 + cc * 8);
#pragma unroll
                for (int e = 0; e < 4; ++e) { VT[(8 * cc + 2 * e) * PT + j] = (bf16_t)(v[e] & 0xffffu); VT[(8 * cc + 2 * e + 1) * PT + j] = (bf16_t)(v[e] >> 16); }
            }
        }
        bf16_t qraw[TPG], kraw[TPG];
#pragma unroll
        for (int ii = 0; ii < TPG; ++ii) { const size_t rr = (rbase + g * TPG + ii) * H1W + h * 128 + dk; qraw[ii] = H1[rr]; kraw[ii] = H1[rr + 512]; }
        __syncthreads();
        float bl[TPG]; float run = 0.f;
#pragma unroll
        for (int ii = 0; ii < TPG; ++ii) {
            const float* gr = GLS + (g * TPG + ii) * 16; float lg = bgv;
#pragma unroll
            for (int r = 0; r < 16; ++r) lg += gr[r] * wg[r];
            const float ls = fminf(lg, 0.f) - __logf(1.f + __expf(-fabsf(lg)));
            run += ls * (1.f / 16.f); bl[ii] = run;
        }
        TOT[g * 128 + dk] = run;
        __syncthreads();
        float off = 0.f, blast = 0.f;
#pragma unroll
        for (int gg = 0; gg < 4; ++gg) { const float t = TOT[gg * 128 + dk]; blast += t; off += (gg < g) ? t : 0.f; }
#pragma unroll
        for (int ii = 0; ii < TPG; ++ii) {
            const int i = g * TPG + ii; const float b = off + bl[ii];
            const float qv = bf2f(qraw[ii]), kv = bf2f(kraw[ii]);
            QF[i * QP + dk] = (bf16_t)(cvtpk(qv * __expf(b), 0.f) & 0xffffu);
            KF[i * QP + dk] = (bf16_t)(cvtpk(kv * __expf(-b), 0.f) & 0xffffu);
            KT[dk * PT + i] = (bf16_t)(cvtpk(kv * __expf(blast - b), 0.f) & 0xffffu);
        }
        if (g == 0) DEC[dk] = __expf(blast);
        __syncthreads();
        {
            constexpr int NT = C / 16;
            if (C == 64 || w == 0) {
                const int ti = (C == 64) ? (w >> 1) : 0;
#pragma unroll
                for (int q = 0; q < ((C == 64) ? 2 : 1); ++q) {
                    const int tj = (C == 64) ? (2 * (w & 1) + q) : 0;
                    f32x4 d = {0.f, 0.f, 0.f, 0.f};
                    if (tj <= ti) {
#pragma unroll
                        for (int s = 0; s < 4; ++s) { const bf16x8 a = *(const bf16x8*)(QF + (16 * ti + fr) * QP + 32 * s + 8 * fq); const bf16x8 bb = *(const bf16x8*)(KF + (16 * tj + fr) * QP + 32 * s + 8 * fq); d = MFMA16(a, bb, d); }
                    }
#pragma unroll
                    for (int r = 0; r < 4; ++r) { const int i = 16 * ti + 4 * fq + r, j = 16 * tj + fr; ATT[i * PT + j] = (bf16_t)(cvtpk((j <= i) ? d[r] : 0.f, 0.f) & 0xffffu); }
                }
            }
            f32x4 o[NT];
            bf16x8 sf[4];
#pragma unroll
            for (int s = 0; s < 4; ++s) sf[s] = pack8(S[2 * s], S[2 * s + 1]);
#pragma unroll
            for (int ti = 0; ti < NT; ++ti) { o[ti] = (f32x4){0.f, 0.f, 0.f, 0.f};
#pragma unroll
                for (int s = 0; s < 4; ++s) { const s16x4 lo = *(const s16x4*)(QF + (16 * ti + fr) * QP + 32 * s + 4 * fq), hi = *(const s16x4*)(QF + (16 * ti + fr) * QP + 32 * s + 16 + 4 * fq);
                    const bf16x8 a = __builtin_shufflevector(lo, hi, 0, 1, 2, 3, 4, 5, 6, 7); o[ti] = MFMA16(a, sf[s], o[ti]); } }
            __syncthreads();
#pragma unroll
            for (int ti = 0; ti < NT; ++ti) {
#pragma unroll
                for (int s = 0; s < CP / 32; ++s) { const bf16x8 a = *(const bf16x8*)(ATT + (16 * ti + fr) * PT + 32 * s + 8 * fq); const bf16x8 bb = *(const bf16x8*)(VT + (16 * w + fr) * PT + 32 * s + 8 * fq); o[ti] = MFMA16(a, bb, o[ti]); }
#pragma unroll
                for (int r = 0; r < 4; ++r) OG[(rbase + 16 * ti + 4 * fq + r) * DM + h * 256 + vcol] = (bf16_t)(cvtpk(o[ti][r], 0.f) & 0xffffu);
            }
#pragma unroll
            for (int t = 0; t < 8; ++t) {
                const f32x4 dec = *(const f32x4*)(DEC + 16 * t + 4 * fq);
                S[t] = S[t] * dec;
#pragma unroll
                for (int s = 0; s < CP / 32; ++s) { const bf16x8 a = *(const bf16x8*)(KT + (16 * t + fr) * PT + 32 * s + 8 * fq); const bf16x8 bb = *(const bf16x8*)(VT + (16 * w + fr) * PT + 32 * s + 8 * fq); S[t] = MFMA16(a, bb, S[t]); }
            }
        }
        __syncthreads();
    }
#pragma unroll
    for (int t = 0; t < 8; ++t)
#pragma unroll
        for (int r = 0; r < 4; ++r) S_out[(size_t)(16 * t + 4 * fq + r) * 256 + vcol] = S[t][r];
}

typedef float f32x16 __attribute__((ext_vector_type(16)));
#define MFMA32(a, b, c) __builtin_amdgcn_mfma_f32_32x32x16_bf16((a), (b), (c), 0, 0, 0)
DI int crow32(int i, int h) { return (i & 3) + 8 * (i >> 2) + 4 * h; }
typedef __attribute__((address_space(3))) const char* LDSC;
typedef short v4i16_t __attribute__((ext_vector_type(4)));
DI s16x4 tr_read(LDSC p) { return __builtin_bit_cast(s16x4, __builtin_amdgcn_ds_read_tr16_b64_v4i16((__attribute__((address_space(3))) v4i16_t*)p)); }
DI void attn_unit(unsigned char* lds, const bf16_t* Qp, const bf16_t* Kp, const bf16_t* Vp, bf16_t* Op, int nt_lo, int nt_hi, int kv_len, int nvalid,
                  float lam, const float* gn) {
    constexpr int KP = 136, VP = 72;
    const int tid = threadIdx.x, lane = tid & 63, w = __builtin_amdgcn_readfirstlane(tid >> 6), r = lane & 31, h = lane >> 5;
    const int qt = w & 3, map = w >> 2;
    bf16_t* KS = (bf16_t*)lds;
    bf16_t* VT = (bf16_t*)(lds + 17408);
    float* XCH = (float*)(lds + 36864);
    const bool wact = (qt * 32) < nvalid;
    const int my_nt = (qt < 2) ? nt_lo : nt_hi;
    const int qrow = qt * 32 + r;
    const LDSC vtr0 = (LDSC)lds + 17408 + ((4 * h + ((lane & 15) >> 2)) * KP + 16 * ((lane >> 4) & 1) + 4 * (lane & 3)) * 2;
    bf16x8 qf[4];
#pragma unroll
    for (int s = 0; s < 4; ++s) qf[s] = (wact && qrow < nvalid) ? *(const bf16x8*)(Qp + (size_t)qrow * DM + map * 64 + 16 * s + 8 * h) : (bf16x8){0, 0, 0, 0, 0, 0, 0, 0};
    f32x16 O[4];
#pragma unroll
    for (int n = 0; n < 4; ++n)
#pragma unroll
        for (int i = 0; i < 16; ++i) O[n][i] = 0.f;
    float mref = -INFINITY, lsum = 0.f;
    u32x4 kreg[2], vreg[2];
    const int kkey = tid >> 4, kch = tid & 15;
    const bf16_t* kptr = Kp + (size_t)kkey * DM + kch * 8;
    const bf16_t* vptr = Vp + (size_t)kkey * DM + kch * 8;
#pragma unroll
    for (int it = 0; it < 2; ++it) { kreg[it] = *(const u32x4*)(kptr + (size_t)it * 32 * DM); vreg[it] = *(const u32x4*)(vptr + (size_t)it * 32 * DM); }
    __syncthreads();
    for (int t = 0; t < nt_hi; ++t) {
#pragma unroll
        for (int it = 0; it < 2; ++it) { *(u32x4*)(KS + (kkey + 32 * it) * KP + kch * 8) = kreg[it]; *(u32x4*)(VT + (kkey + 32 * it) * KP + kch * 8) = vreg[it]; }
        __syncthreads();
        if (t + 1 < nt_hi) {
            kptr += (size_t)64 * DM; vptr += (size_t)64 * DM;
#pragma unroll
            for (int it = 0; it < 2; ++it) { kreg[it] = *(const u32x4*)(kptr + (size_t)it * 32 * DM); vreg[it] = *(const u32x4*)(vptr + (size_t)it * 32 * DM); }
        }
        if (wact && t < my_nt) {
            f32x16 Sx[2];
#pragma unroll
            for (int kt = 0; kt < 2; ++kt) {
                f32x16 a;
#pragma unroll
                for (int i = 0; i < 16; ++i) a[i] = 0.f;
#pragma unroll
                for (int s = 0; s < 4; ++s) { const bf16x8 kf = *(const bf16x8*)(KS + (32 * kt + r) * KP + map * 64 + 16 * s + 8 * h); a = MFMA32(kf, qf[s], a); }
                Sx[kt] = a;
            }
            const int key0 = t * 64;
            if (key0 + 64 > kv_len) {
#pragma unroll
                for (int kt = 0; kt < 2; ++kt)
#pragma unroll
                    for (int i = 0; i < 16; ++i) if (key0 + 32 * kt + crow32(i, h) >= kv_len) Sx[kt][i] = -INFINITY;
            }
            float mx = -INFINITY;
#pragma unroll
            for (int kt = 0; kt < 2; ++kt)
#pragma unroll
                for (int i = 0; i < 16; ++i) mx = fmaxf(mx, Sx[kt][i]);
            mx = fmaxf(mx, __shfl_xor(mx, 32));
            if (__any(mx > mref + 8.f)) {
                const float mnew = fmaxf(mref, mx); const float corr = __builtin_amdgcn_exp2f(mref - mnew); mref = mnew; lsum *= corr;
#pragma unroll
                for (int n = 0; n < 4; ++n) O[n] = O[n] * corr;
            }
            float ps = 0.f;
#pragma unroll
            for (int kt = 0; kt < 2; ++kt)
#pragma unroll
                for (int i = 0; i < 16; ++i) { const float pv = __builtin_amdgcn_exp2f(Sx[kt][i] - mref); Sx[kt][i] = pv; ps += pv; }
            lsum += ps;
            bf16x8 pf[4];
#pragma unroll
            for (int sp = 0; sp < 4; ++sp) { const int kt = sp >> 1, b8 = 8 * (sp & 1); u32x4 pk;
                pk.x = cvtpk(Sx[kt][b8], Sx[kt][b8 + 1]); pk.y = cvtpk(Sx[kt][b8 + 2], Sx[kt][b8 + 3]); pk.z = cvtpk(Sx[kt][b8 + 4], Sx[kt][b8 + 5]); pk.w = cvtpk(Sx[kt][b8 + 6], Sx[kt][b8 + 7]);
                pf[sp] = __builtin_bit_cast(bf16x8, pk); }
#pragma unroll
            for (int n = 0; n < 4; ++n)
#pragma unroll
                for (int sp = 0; sp < 4; ++sp) {
                    const s16x4 lo = tr_read(vtr0 + ((16 * sp) * KP + 32 * n) * 2), hi = tr_read(vtr0 + ((16 * sp + 8) * KP + 32 * n) * 2);
                    const bf16x8 vf = __builtin_shufflevector(lo, hi, 0, 1, 2, 3, 4, 5, 6, 7);
                    O[n] = MFMA32(vf, pf[sp], O[n]);
                }
        }
        __syncthreads();
    }
    lsum += __shfl_xor(lsum, 32);
    if (map == 1 && wact) {
        const float sc = lam / lsum;
#pragma unroll
        for (int n = 0; n < 4; ++n)
#pragma unroll
            for (int g = 0; g < 4; ++g) { f32x4 v; v[0] = O[n][4 * g] * sc; v[1] = O[n][4 * g + 1] * sc; v[2] = O[n][4 * g + 2] * sc; v[3] = O[n][4 * g + 3] * sc;
                *(f32x4*)(XCH + (size_t)((qt * 16 + n * 4 + g) * 64 + lane) * 4) = v; }
    }
    __syncthreads();
    if (map == 0 && wact) {
        const float inv = 1.f / lsum; float ss = 0.f;
#pragma unroll
        for (int n = 0; n < 4; ++n)
#pragma unroll
            for (int g = 0; g < 4; ++g) { const f32x4 x = *(const f32x4*)(XCH + (size_t)((qt * 16 + n * 4 + g) * 64 + lane) * 4);
#pragma unroll
                for (int j = 0; j < 4; ++j) { const float o = O[n][4 * g + j] * inv - x[j]; O[n][4 * g + j] = o; ss += o * o; } }
        ss += __shfl_xor(ss, 32);
        const float rstd = (1.f - LAMBDA_INIT) / sqrtf(ss * (1.f / 128.f) + RMS_EPS);
        if (qrow < nvalid) {
#pragma unroll
            for (int n = 0; n < 4; ++n)
#pragma unroll
                for (int g = 0; g < 4; ++g) { const int dv0 = 32 * n + 8 * g + 4 * h; const f32x4 gv = *(const f32x4*)(gn + dv0);
                    u32x2 wv; wv.x = cvtpk(O[n][4 * g] * gv[0] * rstd, O[n][4 * g + 1] * gv[1] * rstd); wv.y = cvtpk(O[n][4 * g + 2] * gv[2] * rstd, O[n][4 * g + 3] * gv[3] * rstd);
                    *(u32x2*)(Op + (size_t)qrow * DM + dv0) = wv; }
        }
    }
}

constexpr int NPHASE = 16;
__global__ void __launch_bounds__(NTHREADS) yoco_fwd(Params p) {
    extern __shared__ __attribute__((aligned(16))) unsigned char lds[];
    cg::grid_group grid = cg::this_grid();
    const int tid = threadIdx.x, lane = tid & 63, wave = __builtin_amdgcn_readfirstlane(tid >> 6);
    const int G = gridDim.x, bx = blockIdx.x;
    const int gw = bx * NWAVES + wave, ngw = G * NWAVES;
    unsigned char* ws = p.ws;
    bf16_t* XB = (bf16_t*)(ws + WS_XB);
    float* XR = p.out;
    float* GL = (float*)(ws + WS_GL);
    bf16_t* H1 = (bf16_t*)(ws + WS_BIG + BIG_H1);
    bf16_t* OG = (bf16_t*)(ws + WS_BIG + BIG_OG);
    bf16_t* U = (bf16_t*)(ws + WS_BIG + BIG_U);
    bf16_t* KB = (bf16_t*)(ws + WS_BIG + BIG_KB);
    bf16_t* VB = (bf16_t*)(ws + WS_BIG + BIG_VB);
    bf16_t* QB = (bf16_t*)(ws + WS_BIG + BIG_QB);
    bf16_t* OB = (bf16_t*)(ws + WS_BIG + BIG_OB);
    bf16_t* KSb = (bf16_t*)(ws + WS_KS);
    bf16_t* VSb = (bf16_t*)(ws + WS_VS);
    const int lo = p.ph_lo, hi = p.ph_hi;
#define IN(k) (lo <= (k) && (k) < hi)
#define SEAM(k) do { if (IN(k) && IN((k) + 1)) grid.sync(); } while (0)
#define LDSP ((PG8_LAS unsigned char*)lds)
#ifndef PROBE_DUP
#define PROBE_DUP -1
#endif
#define REPS(k) ((PROBE_DUP == (k)) ? 2 : 1)
#define PH(k) if (IN(k)) for (int rep_ = 0; rep_ < REPS(k); ++rep_, (rep_ < REPS(k) ? grid.sync() : (void)0))

    PH(0) { phase_prep(p, lds, gw, ngw, wave, lane); }
    SEAM(0);
    PH(1) { pg8::Gemm g{XB, (const bf16_t*)(ws + WS_WIN), NROWS, NWIN, 1024}; pg8::StaticOrder S; S.init(NROWS, NWIN, G, bx); EpiH1 E{H1, GL};
        pg8::gemm_phase<EpiH1, pg8::StaticOrder, true, true>(LDSP, g, S, E); }
    SEAM(1);
    PH(2) {
        for (int u = bx; u < 512; u += G) {
            if (u < 256) { const int b = u >> 3, h = (u >> 1) & 3, half = u & 1;
                gla_unit<64>(lds, H1, GL, OG, (size_t)b * SEQ, SEQ / 64, h, half, nullptr, p.out + OUT_SP + (size_t)(b * 4 + h) * 128 * 256, p.in[6], p.in[7]); }
            else { const int v = u - 256, b = v >> 3, h = (v >> 1) & 3, half = v & 1;
                gla_unit<16>(lds, H1, GL, OG, (size_t)NPROMPT + (size_t)b * DEC_SEQ, 1, h, half, p.in[2] + (size_t)(b * 4 + h) * 128 * 256, p.out + OUT_SS + (size_t)(b * 4 + h) * 128 * 256, p.in[6], p.in[7]); }
        }
    }
    SEAM(2);
    PH(3) { phase_ognorm(OG, H1, p.in[8], gw, ngw, lane); }
    SEAM(3);
    PH(4) { pg8::Gemm g{OG, (const bf16_t*)(ws + WS_WOA), NROWS, 1024, 1024}; pg8::StaticOrder S; S.init(NROWS, 1024, G, bx); EpiRes E{XR};
        pg8::gemm_phase<EpiRes, pg8::StaticOrder, true, true>(LDSP, g, S, E); }
    SEAM(4);
    PH(5) { phase_ln(XR, XB, p.in[17], p.in[18], gw, ngw, lane); }
    SEAM(5);
    PH(6) { pg8::Gemm g{XB, (const bf16_t*)(ws + WS_WUP0), NROWS, DFF, 1024}; pg8::StaticOrder S; S.init(NROWS, DFF, G, bx); EpiUp E{U};
        pg8::gemm_phase<EpiUp, pg8::StaticOrder, true, true>(LDSP, g, S, E); }
    SEAM(6);
    PH(7) { pg8::Gemm g{U, (const bf16_t*)(ws + WS_WDN0), NROWS, 1024, DFF}; pg8::StaticOrder S; S.init(NROWS, 1024, G, bx); EpiRes E{XR};
        pg8::gemm_phase<EpiRes, pg8::StaticOrder, true, true>(LDSP, g, S, E); }
    SEAM(7);
    PH(8) { phase_ln(XR, XB, p.in[17] + 1024, p.in[18] + 1024, gw, ngw, lane); }
    SEAM(8);
    PH(9) { pg8::Gemm g{XB, (const bf16_t*)(ws + WS_WKVQ), NROWS, 3072, 1024}; pg8::StaticOrder S; S.init(NROWS, 3072, G, bx);
        EpiKVQ E{p.out, KB, VB, QB, KSb, VSb, (const float*)(ws + WS_ROPE)};
        pg8::gemm_phase<EpiKVQ, pg8::StaticOrder, true, true>(LDSP, g, S, E); }
    SEAM(9);
    PH(10) {
        const float* lm = p.in[12];
        const float d1 = wave_sum(lm[lane] * lm[64 + lane]), d2 = wave_sum(lm[128 + lane] * lm[192 + lane]);
        const float lam = __expf(d1) - __expf(d2) + LAMBDA_INIT;
        if (G == 256) {
            const int vcu = (bx & 7) * 32 + (bx >> 3), xcd = vcu >> 5, local = vcu & 31, sub = local >> 3, sx = local & 7;
            for (int rd = 0; rd < 8; ++rd) {
                const int u = xcd * 32 + rd * 4 + sub, b = u >> 3, h = u & 7;
                for (int q = 0; q < 2; ++q) {
                    const int i = q ? sx : 15 - sx;
                    const size_t qrow = (size_t)b * SEQ + 128 * i;
                    attn_unit(lds, QB + qrow * DM + h * 128, KB + (size_t)b * SEQ * DM + h * 128, VB + (size_t)b * SEQ * DM + h * 128, OB + qrow * DM + h * 128,
                              2 * i + 1, 2 * i + 2, 1 << 30, 128, lam, p.in[13]);
                }
            }
        } else {
            for (int u = bx; u < 256; u += G) {
                const int b = u >> 3, h = u & 7;
                for (int i = 15; i >= 0; --i) {
                    const size_t qrow = (size_t)b * SEQ + 128 * i;
                    attn_unit(lds, QB + qrow * DM + h * 128, KB + (size_t)b * SEQ * DM + h * 128, VB + (size_t)b * SEQ * DM + h * 128, OB + qrow * DM + h * 128,
                              2 * i + 1, 2 * i + 2, 1 << 30, 128, lam, p.in[13]);
                }
            }
        }
        for (int u = bx; u < 256; u += G) {
            const int b = u >> 3, h = u & 7;
            const size_t qrow = (size_t)NPROMPT + (size_t)b * DEC_SEQ;
            attn_unit(lds, QB + qrow * DM + h * 128, KSb + (size_t)b * KVS_ROWS * DM + h * 128, VSb + (size_t)b * KVS_ROWS * DM + h * 128, OB + qrow * DM + h * 128,
                      17, 17, PAST + DEC_SEQ, DEC_SEQ, lam, p.in[13]);
        }
    }
    SEAM(10);
    PH(11) { pg8::Gemm g{OB, (const bf16_t*)(ws + WS_WOB), NROWS, 1024, 1024}; pg8::StaticOrder S; S.init(NROWS, 1024, G, bx); EpiRes E{XR};
        pg8::gemm_phase<EpiRes, pg8::StaticOrder, true, true>(LDSP, g, S, E); }
    SEAM(11);
    PH(12) { phase_ln(XR, XB, p.in[17] + 2048, p.in[18] + 2048, gw, ngw, lane); }
    SEAM(12);
    PH(13) { pg8::Gemm g{XB, (const bf16_t*)(ws + WS_WUP1), NROWS, DFF, 1024}; pg8::StaticOrder S; S.init(NROWS, DFF, G, bx); EpiUp E{U};
        pg8::gemm_phase<EpiUp, pg8::StaticOrder, true, true>(LDSP, g, S, E); }
    SEAM(13);
    PH(14) { pg8::Gemm g{U, (const bf16_t*)(ws + WS_WDN1), NROWS, 1024, DFF}; pg8::StaticOrder S; S.init(NROWS, 1024, G, bx); EpiRes E{XR};
        pg8::gemm_phase<EpiRes, pg8::StaticOrder, true, true>(LDSP, g, S, E); }
    SEAM(14);
    PH(15) { phase_ln(XR, nullptr, p.in[17] + 3072, p.in[18] + 3072, gw, ngw, lane); }
#undef IN
#undef SEAM
}

#ifndef ONE_LAUNCH
#define ONE_LAUNCH 1
#endif
extern "C" void kernel_launch(void* const* d_in, const int* in_sizes, int n_in, void* d_out, int out_size, void* d_ws, size_t ws_size, hipStream_t stream) {
    static int grid = 0;
    if (grid == 0) {
        if (n_in != 19 || ws_size < WS_END) { fprintf(stderr, "kernel_launch: unexpected n_in %d / ws_size %zu (need %zu)\n", n_in, ws_size, (size_t)WS_END); grid = -1; return; }
        int dev = 0, cus = 0, per_cu = 0;
        hipGetDevice(&dev); hipDeviceGetAttribute(&cus, hipDeviceAttributeMultiprocessorCount, dev);
        if (hipFuncSetAttribute((const void*)yoco_fwd, hipFuncAttributeMaxDynamicSharedMemorySize, LDS_BYTES) != hipSuccess) { fprintf(stderr, "kernel_launch: hipFuncSetAttribute failed\n"); grid = -1; return; }
        if (hipOccupancyMaxActiveBlocksPerMultiprocessor(&per_cu, (const void*)yoco_fwd, NTHREADS, LDS_BYTES) != hipSuccess || per_cu < 1) { fprintf(stderr, "kernel_launch: occupancy query says %d\n", per_cu); per_cu = 1; }
        (void)hipGetLastError();
        grid = cus * 1;
        if (grid <= 0) grid = 256;
    }
    if (grid < 0) return;
    Params p{};
    for (int i = 0; i < 19; ++i) p.in[i] = (const float*)d_in[i];
    p.out = (float*)d_out; p.ws = (unsigned char*)d_ws;
#if ONE_LAUNCH
    p.ph_lo = 0; p.ph_hi = NPHASE;
    void* args[] = {&p};
    hipError_t e = hipLaunchCooperativeKernel((const void*)yoco_fwd, dim3(grid), dim3(NTHREADS), args, LDS_BYTES, stream);
    if (e != hipSuccess) fprintf(stderr, "cooperative launch failed: %s (grid %d)\n", hipGetErrorString(e), grid);
#else
    for (int ph = 0; ph < NPHASE; ++ph) {
        p.ph_lo = ph; p.ph_hi = ph + 1;
        hipLaunchKernelGGL(yoco_fwd, dim3(grid), dim3(NTHREADS), LDS_BYTES, stream, p);
    }
#endif
}
```

```cpp
#include <hip/hip_runtime.h>
#include <hip/hip_cooperative_groups.h>
#include <cstdio>
#include <cstdint>
#include <cmath>
namespace cg = cooperative_groups;
namespace pg8 {
#define PG8_LAS __attribute__((address_space(3)))
typedef unsigned short bf16_t;
typedef short bf16x8 __attribute__((ext_vector_type(8)));
typedef float f32x4 __attribute__((ext_vector_type(4)));
typedef unsigned u32x4 __attribute__((ext_vector_type(4)));
constexpr int BM = 256, BK = 64, HALF = 128, HTB = HALF * BK * 2  , STAGE_BYTES = 8 * HTB, NXCD = 8, WGM = 8;

__host__ __device__ __forceinline__ int lds_byte(int r, int c) { const int st = (r >> 4) * 2 + (c >> 5), rr = r & 15, cc = c & 31, ob = rr * 64 + cc * 2; return st * 1024 + (ob ^ (((ob >> 9) & 1) << 5)); }
__host__ __device__ __forceinline__ void stage_rc(int b, int& R, int& C) { const int st = b / 1024, sb = b % 1024, swz = sb ^ (((sb >> 9) & 1) << 5); R = (st >> 1) * 16 + swz / 64; C = (st & 1) * 32 + (swz % 64) / 2; }
__host__ __device__ __forceinline__ int perm32(int rho) { const int n = rho >> 4, i = rho & 15; return 8 * (i >> 2) + 4 * n + (i & 3); }

struct Unit { int pm, pn, ks, nt; };
struct Gemm { const bf16_t* A; const bf16_t* Bt; int M, N, K; };

struct StaticOrder {
    int nM, nN, nwg, G, c;
    __host__ __device__ void init(int M, int N, int G_, int c_) { nM = M / BM; nN = N / BM; nwg = nM * nN; G = G_; c = c_; }
    __host__ __device__ bool next(int i, Unit& u) const {
        const long L = (long)i * G + c; if (L >= nwg) return false;
        int wgid = (int)L; { const int q = nwg / NXCD, r = nwg % NXCD, xcd = wgid % NXCD, off = wgid / NXCD; wgid = (xcd < r ? xcd * (q + 1) : r * (q + 1) + (xcd - r) * q) + off; }
        const int nig = WGM * nN, gid = wgid / nig, fm = gid * WGM, gsz = (nM - fm) < WGM ? (nM - fm) : WGM;
        u.pm = fm + ((wgid % nig) % gsz); u.pn = (wgid % nig) / gsz; return true;
    }
    __device__ __forceinline__ void a_ready(const Unit&) const {}
    __device__ __forceinline__ void done(const Unit&) const {}
};

struct MixOrder {
    StaticOrder so; int nmain, nN, S, ntm, nts, G, c;
    __device__ void init(int N, int Kext, int S_, int G_, int c_) { so.init(65536, N, G_, c_); nmain = so.nwg; nN = N / BM; S = S_; ntm = Kext / BK; nts = Kext / BK / S_; G = G_; c = c_; }
    __device__ bool next(int i, Unit& u) const {
        const long L = (long)i * G + c;
        if (L < nmain) { so.next(i, u); u.ks = 0; u.nt = ntm; return true; }
        const int e = (int)(L - nmain); if (e >= 2 * nN * S) return false;
        u.pn = e % nN; const int rest = e / nN; u.pm = 256 + (rest & 1); u.ks = rest >> 1; u.nt = nts; return true;
    }
    __device__ __forceinline__ void a_ready(const Unit&) const {}
    __device__ __forceinline__ void done(const Unit&) const {}
};
typedef float f32x2 __attribute__((ext_vector_type(2)));
template <class Epi, class Sched, bool ALIGN_EPI = false, bool SP2 = false>
__device__ __forceinline__ void gemm_phase(PG8_LAS unsigned char* lds, const Gemm g, const Sched& S, const Epi& E) {
    const int tid = threadIdx.x, wid = __builtin_amdgcn_readfirstlane(tid >> 6), lane = tid & 63, wr = wid >> 2, wc = wid & 3, fr = lane & 15, fq = lane >> 4;
    const int K = g.K;
    unsigned voffA[2], voffB[2];
#pragma unroll
    for (int i = 0; i < 2; ++i) { int R, C; stage_rc(tid * 16 + i * 8192, R, C); const int Rb = Epi::PERM ? ((R & ~31) + perm32(R & 31)) : R;
        voffA[i] = (unsigned)(R * K + C) * 2u; voffB[i] = (unsigned)(Rb * K + C) * 2u; }
    const size_t kstep = (size_t)(BK * 2);
    const size_t hstep = (size_t)HALF * K * 2;
    const size_t tstep = 2 * hstep;
    const unsigned ldsw = (unsigned)wid * 1024u;
    const int aoff = lds_byte(wr * 64 + fr, fq * 8), boff = lds_byte(wc * 32 + fr, fq * 8);
#define PG8_SA(b, h) (((b) * 2 + (h)) * HTB)
#define PG8_SB(b, h) ((4 + (b) * 2 + (h)) * HTB)
#define PG8_STAGE(bufoff, gbase, voff) do { _Pragma("unroll") for (int _i = 0; _i < 2; ++_i) \
        __builtin_amdgcn_global_load_lds((const unsigned*)((const char*)(gbase) + (voff)[_i]), (PG8_LAS unsigned*)(lds + (bufoff) + ldsw + _i * 8192), 16, 0, 0); } while (0)
#define PG8_LDA(dst, b, h) do { _Pragma("unroll") for (int m = 0; m < 4; ++m) _Pragma("unroll") for (int k = 0; k < 2; ++k) dst[m][k] = *(const PG8_LAS bf16x8*)(lds + PG8_SA(b, h) + aoff + m * 2048 + k * 1024); } while (0)
#define PG8_LDB(dst, b, h) do { _Pragma("unroll") for (int n = 0; n < 2; ++n) _Pragma("unroll") for (int k = 0; k < 2; ++k) dst[n][k] = *(const PG8_LAS bf16x8*)(lds + PG8_SB(b, h) + boff + n * 2048 + k * 1024); } while (0)
#define PG8_MMA(ai, bj, At, Bt) do { __builtin_amdgcn_s_setprio(1); _Pragma("unroll") for (int m = 0; m < 4; ++m) _Pragma("unroll") for (int n = 0; n < 2; ++n) _Pragma("unroll") for (int k = 0; k < 2; ++k) \
        acc[ai][bj][m][n] = __builtin_amdgcn_mfma_f32_16x16x32_bf16(Bt[n][k], At[m][k], acc[ai][bj][m][n], 0, 0, 0); __builtin_amdgcn_s_setprio(0); } while (0)
#define PG8_WAIT_V(n) asm volatile("s_waitcnt vmcnt(" #n ")" ::: "memory")
#define PG8_WAIT_L(n) asm volatile("s_waitcnt lgkmcnt(" #n ")" ::: "memory")
#define PG8_BAR __builtin_amdgcn_s_barrier()
#define PG8_SCHED __builtin_amdgcn_sched_barrier(0)
    Unit cur, nxt; int ui = 0;
    if (!S.next(0, cur)) return;
    f32x4 acc[2][2][4][2];
#pragma unroll
    for (int a = 0; a < 2; ++a)
#pragma unroll
        for (int b = 0; b < 2; ++b)
#pragma unroll
            for (int m = 0; m < 4; ++m)
#pragma unroll
                for (int n = 0; n < 2; ++n) acc[a][b][m][n] = (f32x4){0.f, 0.f, 0.f, 0.f};
    bf16x8 At[4][2], B0[2][2], B1[2][2];
    const char* cA = (const char*)g.A + (size_t)cur.pm * tstep + (size_t)cur.ks * cur.nt * (BK * 2); const char* cB = (const char*)g.Bt + (size_t)cur.pn * tstep + (size_t)cur.ks * cur.nt * (BK * 2);
    S.a_ready(cur);
    if constexpr (SP2) {
        PG8_STAGE(PG8_SB(0, 0), cB, voffB); PG8_STAGE(PG8_SB(0, 1), cB + hstep, voffB); PG8_STAGE(PG8_SA(0, 0), cA, voffA); PG8_STAGE(PG8_SA(0, 1), cA + hstep, voffA);
        if (wr == 1) PG8_BAR;
        PG8_WAIT_V(2); PG8_BAR;
        PG8_STAGE(PG8_SB(1, 0), cB + kstep, voffB); PG8_STAGE(PG8_SA(1, 0), cA + kstep, voffA); PG8_STAGE(PG8_SB(1, 1), cB + hstep + kstep, voffB);
        PG8_WAIT_V(6); PG8_BAR;
    } else {
        PG8_STAGE(PG8_SB(0, 0), cB, voffB); PG8_STAGE(PG8_SA(0, 0), cA, voffA); PG8_STAGE(PG8_SB(0, 1), cB + hstep, voffB); PG8_STAGE(PG8_SA(0, 1), cA + hstep, voffA);
        if (wr == 1) PG8_BAR;
        PG8_WAIT_V(4); PG8_BAR;
        PG8_STAGE(PG8_SB(1, 0), cB + kstep, voffB); PG8_STAGE(PG8_SA(1, 0), cA + kstep, voffA); PG8_STAGE(PG8_SB(1, 1), cB + hstep + kstep, voffB);
        PG8_WAIT_V(6); PG8_BAR;
    }
    for (;;) {
        const bool has_next = S.next(ui + 1, nxt);
        const char* nA = has_next ? (const char*)g.A + (size_t)nxt.pm * tstep + (size_t)nxt.ks * nxt.nt * (BK * 2) : cA; const char* nB = has_next ? (const char*)g.Bt + (size_t)nxt.pn * tstep + (size_t)nxt.ks * nxt.nt * (BK * 2) : cB;
        const int nt = cur.nt;
        for (int t = 0; t < nt; t += 2) {
            const bool last = (t == nt - 2);
            const char* a1 = cA + (size_t)(t + 1) * kstep;
            const char* a2 = last ? nA : cA + (size_t)(t + 2) * kstep; const char* b2 = last ? nB : cB + (size_t)(t + 2) * kstep;
            const char* a3 = a2 + kstep; const char* b3 = b2 + kstep;
            if (last && has_next) S.a_ready(nxt);
            if constexpr (SP2) {
            PG8_LDB(B0, 0, 0); PG8_LDB(B1, 0, 1); PG8_SCHED; PG8_LDA(At, 0, 0); PG8_STAGE(PG8_SA(1, 1), a1 + hstep, voffA);
            PG8_WAIT_V(8); PG8_WAIT_L(0); PG8_BAR; PG8_MMA(0, 0, At, B0); PG8_MMA(0, 1, At, B1); PG8_BAR; PG8_SCHED;
            PG8_LDA(At, 0, 1); PG8_STAGE(PG8_SB(0, 0), b2, voffB); PG8_STAGE(PG8_SB(0, 1), b2 + hstep, voffB); PG8_STAGE(PG8_SA(0, 0), a2, voffA);
            PG8_WAIT_V(8); PG8_WAIT_L(0); PG8_BAR; PG8_MMA(1, 0, At, B0); PG8_MMA(1, 1, At, B1); PG8_BAR; PG8_SCHED;
            PG8_LDB(B0, 1, 0); PG8_LDB(B1, 1, 1); PG8_SCHED; PG8_LDA(At, 1, 0); PG8_STAGE(PG8_SA(0, 1), a2 + hstep, voffA);
            PG8_WAIT_V(8); PG8_WAIT_L(0); PG8_BAR; PG8_MMA(0, 0, At, B0); PG8_MMA(0, 1, At, B1); PG8_BAR; PG8_SCHED;
            PG8_LDA(At, 1, 1); PG8_STAGE(PG8_SB(1, 0), b3, voffB); PG8_STAGE(PG8_SB(1, 1), b3 + hstep, voffB); PG8_STAGE(PG8_SA(1, 0), a3, voffA);
            PG8_WAIT_V(8); PG8_WAIT_L(0); PG8_BAR; PG8_MMA(1, 0, At, B0); PG8_MMA(1, 1, At, B1); PG8_BAR; PG8_SCHED;
            } else {
            PG8_LDB(B0, 0, 0); PG8_SCHED; PG8_LDA(At, 0, 0); PG8_STAGE(PG8_SA(1, 1), a1 + hstep, voffA);
            PG8_WAIT_L(8); PG8_BAR; PG8_WAIT_L(0); PG8_MMA(0, 0, At, B0); PG8_BAR; PG8_SCHED;
            PG8_LDB(B1, 0, 1); PG8_STAGE(PG8_SB(0, 0), b2, voffB);
            PG8_BAR; PG8_WAIT_L(0); PG8_MMA(0, 1, At, B1); PG8_BAR;
            PG8_LDA(At, 0, 1); PG8_STAGE(PG8_SA(0, 0), a2, voffA);
            PG8_BAR; PG8_WAIT_L(0); PG8_MMA(1, 0, At, B0); PG8_BAR; PG8_SCHED;
            PG8_STAGE(PG8_SB(0, 1), b2 + hstep, voffB);
            PG8_WAIT_V(6); PG8_BAR; PG8_MMA(1, 1, At, B1); PG8_BAR;
            PG8_LDB(B0, 1, 0); PG8_SCHED; PG8_LDA(At, 1, 0); PG8_STAGE(PG8_SA(0, 1), a2 + hstep, voffA);
            PG8_WAIT_L(8); PG8_BAR; PG8_WAIT_L(0); PG8_MMA(0, 0, At, B0); PG8_BAR; PG8_SCHED;
            PG8_LDB(B1, 1, 1); PG8_STAGE(PG8_SB(1, 0), b3, voffB);
            PG8_BAR; PG8_WAIT_L(0); PG8_MMA(0, 1, At, B1); PG8_BAR;
            PG8_LDA(At, 1, 1); PG8_STAGE(PG8_SA(1, 0), a3, voffA);
            PG8_BAR; PG8_WAIT_L(0); PG8_MMA(1, 0, At, B0); PG8_BAR; PG8_SCHED;
            PG8_STAGE(PG8_SB(1, 1), b3 + hstep, voffB);
            PG8_WAIT_V(6); PG8_BAR; PG8_MMA(1, 1, At, B1); PG8_BAR;
            }
        }
        if constexpr (ALIGN_EPI) { if (wr == 0) PG8_BAR; }
        if constexpr (!Epi::AFTER_DRAIN) { E(acc, cur, wr, wc, fr, fq); S.done(cur); }
        if (!has_next) break;
#pragma unroll
        for (int a = 0; a < 2; ++a)
#pragma unroll
            for (int b = 0; b < 2; ++b)
#pragma unroll
                for (int m = 0; m < 4; ++m)
#pragma unroll
                    for (int n = 0; n < 2; ++n) acc[a][b][m][n] = (f32x4){0.f, 0.f, 0.f, 0.f};
        cur = nxt; cA = nA; cB = nB; ++ui;
        if constexpr (ALIGN_EPI) { if (wr == 1) PG8_BAR; }
    }
    PG8_WAIT_V(0);
    if constexpr (!ALIGN_EPI) { if (wr == 0) PG8_BAR; }
    PG8_BAR;
    if constexpr (Epi::AFTER_DRAIN) { E.fused(acc, cur, wr, wc, fr, fq, lds, wid, lane); S.done(cur); }
#undef PG8_SA
#undef PG8_SB
#undef PG8_STAGE
#undef PG8_LDA
#undef PG8_LDB
#undef PG8_MMA
#undef PG8_WAIT_V
#undef PG8_WAIT_L
#undef PG8_BAR
#undef PG8_SCHED
}
}

typedef unsigned short bf16_t;
typedef short bf16x8 __attribute__((ext_vector_type(8)));
typedef short s16x4 __attribute__((ext_vector_type(4)));
typedef float f32x4 __attribute__((ext_vector_type(4)));
typedef float f32x2v __attribute__((ext_vector_type(2)));
typedef __bf16 bf16x2_t __attribute__((ext_vector_type(2)));
typedef unsigned u32x4 __attribute__((ext_vector_type(4)));
typedef unsigned u32x2 __attribute__((ext_vector_type(2)));

constexpr int DM = 1024;
constexpr int NPROMPT = 32 * 2048;
constexpr int NSAMPLE = 32 * 16;
constexpr int NROWS = NPROMPT + NSAMPLE;
constexpr int SEQ = 2048, DEC_SEQ = 16, PAST = 1024, KVS_ROWS = 1088;
constexpr int H1W = 3072;
constexpr int NWIN = 3328;
constexpr int DFF = 4096;
constexpr float ALPHA = 1.4142135623730951f;
constexpr float LAMBDA_INIT = 0.35550906759096934f;
constexpr float LN_EPS = 1e-5f, RMS_EPS = 1e-5f;
constexpr float QSCALE_B = 0.18033688011112042f;
constexpr float QSCALE_A = 0.08838834764831845f;

constexpr size_t MiB = 1u << 20;
constexpr size_t WS_WIN = 0, WS_WOA = 7 * MiB, WS_WKVQ = 9 * MiB, WS_WOB = 15 * MiB, WS_WUP0 = 17 * MiB, WS_WUP1 = 25 * MiB,
                 WS_WDN0 = 33 * MiB, WS_WDN1 = 41 * MiB, WS_ROPE = 49 * MiB, WS_GL = 50 * MiB, WS_XB = 56 * MiB,
                 WS_KS = 186 * MiB, WS_VS = 254 * MiB, WS_BIG = 322 * MiB;
constexpr size_t BIG_H1 = 0, BIG_OG = (size_t)NROWS * H1W * 2, BIG_U = 0, BIG_KB = 0, BIG_VB = 128 * MiB, BIG_QB = 256 * MiB, BIG_OB = 385 * MiB;
constexpr size_t WS_CTL = 55 * MiB + 768 * 1024, CTL_BYTES = 16384;
constexpr size_t WS_STATS = 55 * MiB, WS_PART = WS_BIG + 516 * MiB;
constexpr size_t WS_ATTG = WS_PART + 30 * MiB, WS_DECG = WS_ATTG + 33 * MiB;
constexpr size_t WS_END = WS_DECG + 3 * MiB;
static_assert(BIG_OG + (size_t)NROWS * DM * 2 <= 516 * MiB, "big region");
static_assert(BIG_OB + (size_t)NROWS * DM * 2 <= 516 * MiB, "big region");
static_assert((size_t)NROWS * DFF * 2 <= 516 * MiB, "big region");

constexpr size_t OUT_Y = 0, OUT_SP = 67633152, OUT_KP = 71827456, OUT_VP = 138936320, OUT_SS = 206045184, OUT_KSMP = 210239488, OUT_VSMP = 210763776;

constexpr int NTHREADS = 512, NWAVES = 8;
constexpr int LDS_BYTES = 147456;

#define DI __device__ __forceinline__
DI unsigned cvtpk(float lo, float hi) { f32x2v v = {lo, hi}; bf16x2_t b = __builtin_convertvector(v, bf16x2_t); return __builtin_bit_cast(unsigned, b); }
DI float bf2f(unsigned short h) { return __uint_as_float(((unsigned)h) << 16); }
DI float bflo(unsigned w) { return __uint_as_float(w << 16); }
DI float bfhi(unsigned w) { return __uint_as_float(w & 0xffff0000u); }
DI bf16x8 pack8(f32x4 a, f32x4 b) { u32x4 p; p.x = cvtpk(a[0], a[1]); p.y = cvtpk(a[2], a[3]); p.z = cvtpk(b[0], b[1]); p.w = cvtpk(b[2], b[3]); return __builtin_bit_cast(bf16x8, p); }
#define MFMA16(a, b, c) __builtin_amdgcn_mfma_f32_16x16x32_bf16((a), (b), (c), 0, 0, 0)

struct Params { const float* in[19]; float* out; unsigned char* ws; int ph_lo, ph_hi; };

struct EpiH1 {
    static constexpr bool PERM = true, AFTER_DRAIN = false;
    bf16_t* H1; float* GL;
    DI void operator()(const pg8::f32x4 (&acc)[2][2][4][2], const pg8::Unit& u, int wr, int wc, int fr, int fq) const {
        const int row0 = u.pm * 256 + wr * 64 + fr;
        if (u.pn < 12) {
            const float sc = (u.pn < 2) ? QSCALE_A : 1.0f;
            const int col0 = u.pn * 256 + wc * 32 + 8 * fq;
#pragma unroll
            for (int ai = 0; ai < 2; ++ai)
#pragma unroll
                for (int m = 0; m < 4; ++m) { bf16_t* rowp = H1 + (size_t)(row0 + ai * 128 + m * 16) * H1W + col0;
#pragma unroll
                    for (int bj = 0; bj < 2; ++bj) { f32x4 v0 = acc[ai][bj][m][0] * sc, v1 = acc[ai][bj][m][1] * sc; u32x4 w;
                        w.x = cvtpk(v0[0], v0[1]); w.y = cvtpk(v0[2], v0[3]); w.z = cvtpk(v1[0], v1[1]); w.w = cvtpk(v1[2], v1[3]);
                        *(u32x4*)(rowp + bj * 128) = w; } }
        } else {
            if (wc == 0 && fq < 2) {
#pragma unroll
                for (int ai = 0; ai < 2; ++ai)
#pragma unroll
                    for (int m = 0; m < 4; ++m) { float* rowp = GL + (size_t)(row0 + ai * 128 + m * 16) * 16 + 8 * fq;
                        *(f32x4*)(rowp) = acc[ai][0][m][0]; *(f32x4*)(rowp + 4) = acc[ai][0][m][1]; }
            }
        }
    }
};
struct EpiRes {
    static constexpr bool PERM = false, AFTER_DRAIN = false;
    float* Z; const float* xp; const float* xs; const float* stats; const float* g; const float* b; float* part; int mode;
    DI void operator()(const pg8::f32x4 (&acc)[2][2][4][2], const pg8::Unit& u, int wr, int wc, int fr, int fq) const {
        const int row0 = u.pm * 256 + wr * 64 + fr, col0 = u.pn * 256 + wc * 32 + 4 * fq;
        if (u.ks > 0) {
            float* pb = part + ((size_t)(u.ks - 1) * NSAMPLE + (row0 - NPROMPT)) * DM + col0;
#pragma unroll
            for (int ai = 0; ai < 2; ++ai)
#pragma unroll
                for (int m = 0; m < 4; ++m) { float* rowp = pb + (size_t)(ai * 128 + m * 16) * DM;
#pragma unroll
                    for (int bj = 0; bj < 2; ++bj)
#pragma unroll
                        for (int n = 0; n < 2; ++n) *(f32x4*)(rowp + bj * 128 + n * 16) = acc[ai][bj][m][n]; }
            return;
        }
        if (mode == 0) {
#pragma unroll
            for (int ai = 0; ai < 2; ++ai)
#pragma unroll
                for (int m = 0; m < 4; ++m) { const int row = row0 + ai * 128 + m * 16;
                    const float* xr = ((row < NPROMPT) ? xp + (size_t)row * DM : xs + (size_t)(row - NPROMPT) * DM) + col0; float* zr = Z + (size_t)row * DM + col0;
#pragma unroll
                    for (int bj = 0; bj < 2; ++bj)
#pragma unroll
                        for (int n = 0; n < 2; ++n) { const f32x4 x = *(const f32x4*)(xr + bj * 128 + n * 16); *(f32x4*)(zr + bj * 128 + n * 16) = x * ALPHA + acc[ai][bj][m][n]; } }
        } else {
#pragma unroll
            for (int bj = 0; bj < 2; ++bj)
#pragma unroll
                for (int n = 0; n < 2; ++n) { const int c = col0 + bj * 128 + n * 16; const f32x4 gv = *(const f32x4*)(g + c), bv = *(const f32x4*)(b + c);
#pragma unroll
                    for (int ai = 0; ai < 2; ++ai)
#pragma unroll
                        for (int m = 0; m < 4; ++m) { const int row = row0 + ai * 128 + m * 16; const f32x2v st = *(const f32x2v*)(stats + 2 * (size_t)row);
                            float* zp = Z + (size_t)row * DM + c; const f32x4 z = *(const f32x4*)zp; *(f32x4*)zp = ((z - st.x) * st.y * gv + bv) * ALPHA + acc[ai][bj][m][n]; } }
        }
    }
};
struct EpiUp {
    static constexpr bool PERM = true, AFTER_DRAIN = false;
    bf16_t* U;
    DI void operator()(const pg8::f32x4 (&acc)[2][2][4][2], const pg8::Unit& u, int wr, int wc, int fr, int fq) const {
        const int row0 = u.pm * 256 + wr * 64 + fr, col0 = u.pn * 256 + wc * 32 + 8 * fq;
#pragma unroll
        for (int ai = 0; ai < 2; ++ai)
#pragma unroll
            for (int m = 0; m < 4; ++m) { bf16_t* rowp = U + (size_t)(row0 + ai * 128 + m * 16) * DFF + col0;
#pragma unroll
                for (int bj = 0; bj < 2; ++bj) { f32x4 v0 = acc[ai][bj][m][0], v1 = acc[ai][bj][m][1];
#pragma unroll
                    for (int i = 0; i < 4; ++i) { float a = fmaxf(v0[i], 0.f), b = fmaxf(v1[i], 0.f); v0[i] = a * a; v1[i] = b * b; }
                    u32x4 w; w.x = cvtpk(v0[0], v0[1]); w.y = cvtpk(v0[2], v0[3]); w.z = cvtpk(v1[0], v1[1]); w.w = cvtpk(v1[2], v1[3]);
                    *(u32x4*)(rowp + bj * 128) = w; } }
    }
};
struct EpiKVQ {
    static constexpr bool PERM = false, AFTER_DRAIN = false;
    float* out; bf16_t *KB, *VB, *QB, *KS, *VS; const float* rope;
    DI void operator()(const pg8::f32x4 (&acc)[2][2][4][2], const pg8::Unit& u, int wr, int wc, int fr, int fq) const {
        const int kind = u.pn >> 2;
        const int colt = (u.pn & 3) * 256 + wc * 32 + 4 * fq;
        const bool do_rope = (kind != 1) && ((wc & 1) == 0);
#pragma unroll
        for (int ai = 0; ai < 2; ++ai)
#pragma unroll
            for (int m = 0; m < 4; ++m) {
                const int row = u.pm * 256 + wr * 64 + fr + ai * 128 + m * 16;
                const bool smp = row >= NPROMPT; const int rs = row - NPROMPT;
                const int pos = smp ? (PAST + (rs & 15)) : (row & (SEQ - 1));
                float* of; bf16_t* ob;
                if (kind == 0) { of = smp ? out + OUT_KSMP + (size_t)rs * DM : out + OUT_KP + (size_t)row * DM;
                                 ob = smp ? KS + ((size_t)(rs >> 4) * KVS_ROWS + PAST + (rs & 15)) * DM : KB + (size_t)row * DM; }
                else if (kind == 1) { of = smp ? out + OUT_VSMP + (size_t)rs * DM : out + OUT_VP + (size_t)row * DM;
                                 ob = smp ? VS + ((size_t)(rs >> 4) * KVS_ROWS + PAST + (rs & 15)) * DM : VB + (size_t)row * DM; }
                else { of = nullptr; ob = QB + (size_t)row * DM; }
#pragma unroll
                for (int bj = 0; bj < 2; ++bj)
#pragma unroll
                    for (int n = 0; n < 2; ++n) {
                        f32x4 v = acc[ai][bj][m][n];
                        if (n == 0 && do_rope) {
                            f32x4 pr; pr[0] = __shfl_xor(v[0], 32); pr[1] = __shfl_xor(v[1], 32); pr[2] = __shfl_xor(v[2], 32); pr[3] = __shfl_xor(v[3], 32);
                            const float* rp = rope + (size_t)pos * 16 + 8 * (fq & 1);
                            const f32x4 cs0 = *(const f32x4*)rp, cs1 = *(const f32x4*)(rp + 4);
                            const float sg = (fq < 2) ? -1.f : 1.f;
                            v[0] = v[0] * cs0[0] + sg * pr[0] * cs0[1]; v[1] = v[1] * cs0[2] + sg * pr[1] * cs0[3];
                            v[2] = v[2] * cs1[0] + sg * pr[2] * cs1[1]; v[3] = v[3] * cs1[2] + sg * pr[3] * cs1[3];
                        }
                        const int col = colt + bj * 128 + n * 16;
                        if (kind == 2) v = v * QSCALE_B; else *(f32x4*)(of + col) = v;
                        u32x2 w; w.x = cvtpk(v[0], v[1]); w.y = cvtpk(v[2], v[3]); *(u32x2*)(ob + col) = w;
                    }
            }
    }
};

DI float wave_sum(float v) {
#pragma unroll
    for (int o = 1; o < 64; o <<= 1) v += __shfl_xor(v, o);
    return v;
}
DI void transpose_item(const float* W, int ldw, int col0, int K, int ncols, bf16_t* WT, int row_off, float* scr, int item, int lane) {
    const int nblk = ncols / 32, kb = item / nblk, nb = item % nblk, k0 = 64 * kb, n0 = 32 * nb;
#pragma unroll 8
    for (int i = 0; i < 32; ++i) { const int kk = 2 * i + (lane >> 5); scr[kk * 33 + (lane & 31)] = W[(size_t)(k0 + kk) * ldw + col0 + n0 + (lane & 31)]; }
    asm volatile("s_waitcnt lgkmcnt(0)" ::: "memory");
    const int c = lane & 7;
#pragma unroll
    for (int j = 0; j < 4; ++j) { const int n = (lane >> 3) + 8 * j; const float* s = scr + (8 * c) * 33 + n;
        u32x4 o; o.x = cvtpk(s[0 * 33], s[1 * 33]); o.y = cvtpk(s[2 * 33], s[3 * 33]); o.z = cvtpk(s[4 * 33], s[5 * 33]); o.w = cvtpk(s[6 * 33], s[7 * 33]);
        *(u32x4*)(WT + (size_t)(row_off + n0 + n) * K + k0 + 8 * c) = o; }
    asm volatile("s_waitcnt lgkmcnt(0)" ::: "memory");
}
DI void cvt_row(const float* src, bf16_t* dstb, float* dstf, int lane) {
    const f32x4* s = (const f32x4*)src + lane;
    f32x4 v[4];
#pragma unroll
    for (int j = 0; j < 4; ++j) v[j] = s[64 * j];
    u32x2* o = (u32x2*)dstb + lane;
#pragma unroll
    for (int j = 0; j < 4; ++j) { u32x2 w; w.x = cvtpk(v[j][0], v[j][1]); w.y = cvtpk(v[j][2], v[j][3]); o[64 * j] = w; }
    if (dstf) { f32x4* f = (f32x4*)dstf + lane;
#pragma unroll
        for (int j = 0; j < 4; ++j) f[64 * j] = v[j]; }
}

DI void phase_prep(const Params& p, unsigned char* lds, int gw, int ngw, int wave, int lane) {
    unsigned char* ws = p.ws;
    float* scr = (float*)(lds + wave * 16384);
    constexpr int I_IN = 16 * 96, I_SQ = 16 * 32, I_KV = 16 * 64, I_UP = 16 * 128, I_DN = 64 * 32;
    constexpr int NIT = I_IN + I_SQ + I_KV + I_SQ + I_SQ + 2 * I_UP + 2 * I_DN;
    for (int it = gw; it < NIT; it += ngw) {
        int r = it;
        if (r < I_IN) { transpose_item(p.in[5], 3088, 0, 1024, 3072, (bf16_t*)(ws + WS_WIN), 0, scr, r, lane); continue; } r -= I_IN;
        if (r < I_SQ) { transpose_item(p.in[9], 1024, 0, 1024, 1024, (bf16_t*)(ws + WS_WOA), 0, scr, r, lane); continue; } r -= I_SQ;
        if (r < I_KV) { transpose_item(p.in[10], 2048, 0, 1024, 2048, (bf16_t*)(ws + WS_WKVQ), 0, scr, r, lane); continue; } r -= I_KV;
        if (r < I_SQ) { transpose_item(p.in[11], 1024, 0, 1024, 1024, (bf16_t*)(ws + WS_WKVQ), 2048, scr, r, lane); continue; } r -= I_SQ;
        if (r < I_SQ) { transpose_item(p.in[14], 1024, 0, 1024, 1024, (bf16_t*)(ws + WS_WOB), 0, scr, r, lane); continue; } r -= I_SQ;
        if (r < I_UP) { transpose_item(p.in[15], 4096, 0, 1024, 4096, (bf16_t*)(ws + WS_WUP0), 0, scr, r, lane); continue; } r -= I_UP;
        if (r < I_UP) { transpose_item(p.in[15] + (size_t)1024 * 4096, 4096, 0, 1024, 4096, (bf16_t*)(ws + WS_WUP1), 0, scr, r, lane); continue; } r -= I_UP;
        if (r < I_DN) { transpose_item(p.in[16], 1024, 0, 4096, 1024, (bf16_t*)(ws + WS_WDN0), 0, scr, r, lane); continue; } r -= I_DN;
        transpose_item(p.in[16] + (size_t)4096 * 1024, 1024, 0, 4096, 1024, (bf16_t*)(ws + WS_WDN1), 0, scr, r, lane);
    }
    for (int rr = gw; rr < 256; rr += ngw) {
        bf16_t* dst = (bf16_t*)(ws + WS_WIN) + (size_t)(3072 + rr) * 1024;
        for (int k = lane; k < 1024; k += 64) { const float v = (rr < 16) ? p.in[5][(size_t)k * 3088 + 3072 + rr] : 0.f; dst[k] = (bf16_t)(cvtpk(v, 0.f) & 0xffffu); }
    }
    for (int r = gw; r < NROWS; r += ngw) {
        const float* src = (r < NPROMPT) ? p.in[0] + (size_t)r * DM : p.in[1] + (size_t)(r - NPROMPT) * DM;
        cvt_row(src, (bf16_t*)(ws + WS_XB) + (size_t)r * DM, nullptr, lane);
    }
    for (int r = gw; r < 2 * 32 * KVS_ROWS; r += ngw) {
        const int which = r / (32 * KVS_ROWS), rr = r % (32 * KVS_ROWS), b = rr / KVS_ROWS, t = rr % KVS_ROWS;
        bf16_t* dst = (bf16_t*)(ws + (which ? WS_VS : WS_KS)) + (size_t)rr * DM;
        if (t < PAST) cvt_row(p.in[which ? 4 : 3] + ((size_t)b * PAST + t) * DM, dst, nullptr, lane);
        else if (t >= PAST + DEC_SEQ) { u32x4 z = {0u, 0u, 0u, 0u}; ((u32x4*)dst)[lane] = z; ((u32x4*)dst)[lane + 64] = z; }
    }
    {
        const double invrev[8] = {0.15915494309189535, 0.03086376340470123, 0.005985185712713705, 0.0011606636412400608,
                                  0.00022507907903927653, 4.364795279280289e-05, 8.464330808241401e-06, 1.6414262627950345e-06};
        float* tab = (float*)(ws + WS_ROPE);
        for (int idx = gw * 64 + lane; idx < 2048 * 8; idx += ngw * 64) {
            const int pos = idx >> 3, i = idx & 7;
            double iv = invrev[0];
#pragma unroll
            for (int q = 1; q < 8; ++q) iv = (i == q) ? invrev[q] : iv;
            const double rev = (double)pos * iv; const float fr = (float)(rev - rint(rev));
            tab[2 * idx] = __builtin_amdgcn_cosf(fr); tab[2 * idx + 1] = __builtin_amdgcn_sinf(fr);
        }
    }
}

DI void phase_ln(float* Z, bf16_t* XB, float* stats, const float* part, int nparts, const float* g, const float* b, bool final, int gw, int ngw, int lane) {
    f32x4 gv[4], bv[4];
#pragma unroll
    for (int j = 0; j < 4; ++j) { gv[j] = ((const f32x4*)g)[lane + 64 * j]; bv[j] = ((const f32x4*)b)[lane + 64 * j]; }
    for (int r = gw; r < NROWS; r += ngw) {
        f32x4* xr = (f32x4*)(Z + (size_t)r * DM) + lane;
        f32x4 v[4]; float s = 0.f;
#pragma unroll
        for (int j = 0; j < 4; ++j) v[j] = xr[64 * j];
        if (r >= NPROMPT) {
            for (int ps = 0; ps < nparts; ++ps) { const f32x4* pr = (const f32x4*)(part + ((size_t)ps * NSAMPLE + (r - NPROMPT)) * DM) + lane;
#pragma unroll
                for (int j = 0; j < 4; ++j) v[j] = v[j] + pr[64 * j]; }
            if (!final) {
#pragma unroll
                for (int j = 0; j < 4; ++j) xr[64 * j] = v[j]; }
        }
#pragma unroll
        for (int j = 0; j < 4; ++j) s += (v[j][0] + v[j][1]) + (v[j][2] + v[j][3]);
        const float mean = wave_sum(s) * (1.f / DM); float s2 = 0.f;
#pragma unroll
        for (int j = 0; j < 4; ++j) { const f32x4 d = v[j] - mean; s2 += (d[0] * d[0] + d[1] * d[1]) + (d[2] * d[2] + d[3] * d[3]); }
        const float rstd = 1.f / sqrtf(wave_sum(s2) * (1.f / DM) + LN_EPS);
#pragma unroll
        for (int j = 0; j < 4; ++j) v[j] = (v[j] - mean) * rstd * gv[j] + bv[j];
        if (final) {
#pragma unroll
            for (int j = 0; j < 4; ++j) xr[64 * j] = v[j];
        } else {
            if (lane == 0) *(f32x2v*)(stats + 2 * (size_t)r) = (f32x2v){mean, rstd};
            u32x2* o = (u32x2*)(XB + (size_t)r * DM) + lane;
#pragma unroll
            for (int j = 0; j < 4; ++j) { u32x2 w; w.x = cvtpk(v[j][0], v[j][1]); w.y = cvtpk(v[j][2], v[j][3]); o[64 * j] = w; }
        }
    }
}

DI void phase_ognorm(bf16_t* OG, const bf16_t* H1, const float* gn, int gw, int ngw, int lane) {
    float g[16];
#pragma unroll
    for (int j = 0; j < 4; ++j) { const f32x4 t = *(const f32x4*)(gn + (16 * lane) % 256 + 4 * j); g[4 * j] = t[0]; g[4 * j + 1] = t[1]; g[4 * j + 2] = t[2]; g[4 * j + 3] = t[3]; }
    for (int r = gw; r < NROWS; r += ngw) {
        u32x4* op = (u32x4*)(OG + (size_t)r * DM + 16 * lane);
        const u32x4* rp = (const u32x4*)(H1 + (size_t)r * H1W + 2048 + 16 * lane);
        const u32x4 o0 = op[0], o1 = op[1], r0 = rp[0], r1 = rp[1];
        float o[16], rr[16];
#pragma unroll
        for (int j = 0; j < 4; ++j) { o[2 * j] = bflo(o0[j]); o[2 * j + 1] = bfhi(o0[j]); o[8 + 2 * j] = bflo(o1[j]); o[8 + 2 * j + 1] = bfhi(o1[j]);
            rr[2 * j] = bflo(r0[j]); rr[2 * j + 1] = bfhi(r0[j]); rr[8 + 2 * j] = bflo(r1[j]); rr[8 + 2 * j + 1] = bfhi(r1[j]); }
        float ss = 0.f;
#pragma unroll
        for (int j = 0; j < 16; ++j) ss += o[j] * o[j];
        ss += __shfl_xor(ss, 1); ss += __shfl_xor(ss, 2); ss += __shfl_xor(ss, 4); ss += __shfl_xor(ss, 8);
        const float rstd = 1.f / sqrtf(ss * (1.f / 256.f) + RMS_EPS);
#pragma unroll
        for (int j = 0; j < 16; ++j) { const float x = rr[j]; o[j] = o[j] * rstd * g[j] * (x / (1.f + __expf(-x))); }
        u32x4 w0, w1;
#pragma unroll
        for (int j = 0; j < 4; ++j) { w0[j] = cvtpk(o[2 * j], o[2 * j + 1]); w1[j] = cvtpk(o[8 + 2 * j], o[8 + 2 * j + 1]); }
        op[0] = w0; op[1] = w1;
    }
}

typedef __attribute__((address_space(3))) const char* LDSC;
typedef short v4i16_t __attribute__((ext_vector_type(4)));
DI s16x4 tr_read(LDSC p) { return __builtin_bit_cast(s16x4, __builtin_amdgcn_ds_read_tr16_b64_v4i16((__attribute__((address_space(3))) v4i16_t*)p)); }

DI short bf_hi(float x) { return (short)(cvtpk(x, 0.f) & 0xffffu); }
DI short bf_lo(float x) { const float hi = bflo(cvtpk(x, 0.f)); return (short)(cvtpk(x - hi, 0.f) & 0xffffu); }
template <int C>
DI void gla_pre(unsigned char* lds, bf16_t* H1, const float* GL, bf16_t* ATTg, float* DECg, size_t rbase, int chunk_id, int h, const float* Wg, const float* bg) {
    constexpr int NT = C / 16, QP = 136, EP = 132;
    const int tid = threadIdx.x, lane = tid & 63, w = __builtin_amdgcn_readfirstlane(tid >> 6), fr = lane & 15, fq = lane >> 4;
    float* EB = (float*)(lds);
    float* DECs = (float*)(lds + 33792);
    bf16_t* QF = (bf16_t*)(lds + 34816);
    bf16_t* KF = (bf16_t*)(lds + 52224);
    const int erow = tid >> 3, ec = (tid & 7) * 16; const bool eact = erow < C;
    u32x4 qr[2], kr[2];
    bf16_t* hrow = H1 + (rbase + (eact ? erow : 0)) * H1W + h * 128 + ec;
    if (eact) { qr[0] = *(const u32x4*)hrow; qr[1] = *(const u32x4*)(hrow + 8); kr[0] = *(const u32x4*)(hrow + 512); kr[1] = *(const u32x4*)(hrow + 520); }
    const int dkc = h * 128 + 16 * w + fr;
    bf16x8 b1, b2;
#pragma unroll
    for (int j = 0; j < 8; ++j) { const float wv = Wg[(8 * (fq & 1) + j) * 512 + dkc]; b1[j] = bf_hi(wv); b2[j] = (fq < 2) ? bf_lo(wv) : (short)0; }
    const float bias = bg[dkc];
    float lsv[NT][4];
#pragma unroll
    for (int ti = 0; ti < NT; ++ti) {
        const float* gp = GL + (rbase + 16 * ti + fr) * 16 + 8 * (fq & 1);
        const f32x4 g0 = *(const f32x4*)gp, g1 = *(const f32x4*)(gp + 4);
        bf16x8 a;
#pragma unroll
        for (int j = 0; j < 4; ++j) { a[j] = (fq < 2) ? bf_hi(g0[j]) : bf_lo(g0[j]); a[4 + j] = (fq < 2) ? bf_hi(g1[j]) : bf_lo(g1[j]); }
        f32x4 d = {bias, bias, bias, bias};
        d = MFMA16(a, b1, d); d = MFMA16(a, b2, d);
#pragma unroll
        for (int r = 0; r < 4; ++r) { const float lg = d[r]; lsv[ti][r] = (fminf(lg, 0.f) - __logf(1.f + __expf(-fabsf(lg)))) * (1.f / 16.f); }
    }
    float base = 0.f;
#pragma unroll
    for (int ti = 0; ti < NT; ++ti) {
        lsv[ti][1] += lsv[ti][0]; lsv[ti][2] += lsv[ti][1]; lsv[ti][3] += lsv[ti][2];
        const float tot = lsv[ti][3];
        const float t0 = __shfl(tot, fr), t1 = __shfl(tot, fr + 16), t2 = __shfl(tot, fr + 32), t3 = __shfl(tot, fr + 48);
        const float excl = ((fq > 0) ? t0 : 0.f) + ((fq > 1) ? t1 : 0.f) + ((fq > 2) ? t2 : 0.f);
#pragma unroll
        for (int r = 0; r < 4; ++r) EB[(16 * ti + 4 * fq + r) * EP + 16 * w + fr] = __expf(base + excl + lsv[ti][r]);
        base += (t0 + t1) + (t2 + t3);
    }
    const float eblast = __expf(base);
    if (fq == 0) { DECs[16 * w + fr] = eblast; DECg[((size_t)chunk_id * 4 + h) * 128 + 16 * w + fr] = eblast; }
    __syncthreads();
    if (eact) {
#pragma unroll
        for (int hh = 0; hh < 2; ++hh) {
            const f32x4 e0 = *(const f32x4*)(EB + erow * EP + ec + 8 * hh), e1 = *(const f32x4*)(EB + erow * EP + ec + 8 * hh + 4);
            const f32x4 d0 = *(const f32x4*)(DECs + ec + 8 * hh), d1 = *(const f32x4*)(DECs + ec + 8 * hh + 4);
            float eb[8] = {e0[0], e0[1], e0[2], e0[3], e1[0], e1[1], e1[2], e1[3]}, dc[8] = {d0[0], d0[1], d0[2], d0[3], d1[0], d1[1], d1[2], d1[3]};
            float qv[8], kv[8];
#pragma unroll
            for (int j = 0; j < 4; ++j) { qv[2 * j] = bflo(qr[hh][j]); qv[2 * j + 1] = bfhi(qr[hh][j]); kv[2 * j] = bflo(kr[hh][j]); kv[2 * j + 1] = bfhi(kr[hh][j]); }
            float qf[8], kf[8], kt[8];
#pragma unroll
            for (int j = 0; j < 8; ++j) { qf[j] = qv[j] * eb[j]; kf[j] = kv[j] * __builtin_amdgcn_rcpf(eb[j]); kt[j] = kf[j] * dc[j]; }
            u32x4 wq, wk, wt;
#pragma unroll
            for (int j = 0; j < 4; ++j) { wq[j] = cvtpk(qf[2 * j], qf[2 * j + 1]); wk[j] = cvtpk(kf[2 * j], kf[2 * j + 1]); wt[j] = cvtpk(kt[2 * j], kt[2 * j + 1]); }
            *(u32x4*)(QF + erow * QP + ec + 8 * hh) = wq; *(u32x4*)(KF + erow * QP + ec + 8 * hh) = wk;
            *(u32x4*)(hrow + 8 * hh) = wq; *(u32x4*)(hrow + 512 + 8 * hh) = wt;
        }
    }
    __syncthreads();
    if (C == 64 || w == 0) {
        const int ti = (C == 64) ? (w >> 1) : 0;
#pragma unroll
        for (int q = 0; q < ((C == 64) ? 2 : 1); ++q) {
            const int tj = (C == 64) ? (2 * (w & 1) + q) : 0;
            f32x4 d = {0.f, 0.f, 0.f, 0.f};
            if (tj <= ti) {
#pragma unroll
                for (int s = 0; s < 4; ++s) { const bf16x8 a = *(const bf16x8*)(QF + (16 * ti + fr) * QP + 32 * s + 8 * fq); const bf16x8 bb = *(const bf16x8*)(KF + (16 * tj + fr) * QP + 32 * s + 8 * fq); d = MFMA16(a, bb, d); }
            }
#pragma unroll
            for (int r = 0; r < 4; ++r) { const int i = 16 * ti + 4 * fq + r, j = 16 * tj + fr; ATTg[(rbase + i) * 256 + h * 64 + j] = (bf16_t)(cvtpk((j <= i) ? d[r] : 0.f, 0.f) & 0xffffu); }
        }
    }
    __syncthreads();
}

template <int C>
DI void gla_seq(unsigned char* lds, const bf16_t* H1, const bf16_t* ATTg, const float* DECg, bf16_t* OG, size_t row0, int nchunks, int chunk_id0, int h, int half,
                const float* S_init, float* S_out) {
    constexpr int CP = (C < 32) ? 32 : C, PT = CP + 8, QP = 136, NT = C / 16, NIT = (C == 64) ? 2 : 1;
    const int tid = threadIdx.x, lane = tid & 63, w = __builtin_amdgcn_readfirstlane(tid >> 6), fr = lane & 15, fq = lane >> 4;
    bf16_t* QF = (bf16_t*)(lds);
    bf16_t* KTL = (bf16_t*)(lds + 17408);
    bf16_t* VS = (bf16_t*)(lds + 34816);
    bf16_t* ATT = (bf16_t*)(lds + 52224);
    float* DEC = (float*)(lds + 61440);
    __syncthreads();
    if (C < 32) { for (int i = tid; i < 61440 / 16; i += NTHREADS) ((u32x4*)lds)[i] = (u32x4){0u, 0u, 0u, 0u}; __syncthreads(); }
    const int vcol = half * 128 + 16 * w + fr;
    f32x4 S[8];
#pragma unroll
    for (int t = 0; t < 8; ++t)
#pragma unroll
        for (int r = 0; r < 4; ++r) S[t][r] = S_init ? S_init[(size_t)(16 * t + 4 * fq + r) * 256 + vcol] : 0.f;
    const int srow = tid >> 4, sch = tid & 15;
    const bool sact = (C == 64) || (tid < 256);
    const int arow = (C == 64) ? (tid >> 3) : (tid >> 1), ach = (C == 64) ? (tid & 7) : (tid & 1);
    const bool aact = (C == 64) || (tid < 32);
    const bf16_t* hp = H1 + (row0 + srow) * H1W + sch * 8;
    const bf16_t* ap = ATTg + (row0 + arow) * 256 + h * 64 + ach * 8;
    const float* dp = DECg + ((size_t)chunk_id0 * 4 + h) * 128 + 4 * tid;
    u32x4 qreg[NIT], kreg[NIT], vreg[NIT], areg; f32x4 dreg;
#define GLA_FETCH() do { if (sact) { _Pragma("unroll") for (int it = 0; it < NIT; ++it) { const bf16_t* q_ = hp + (size_t)it * 32 * H1W; \
        qreg[it] = *(const u32x4*)(q_ + h * 128); kreg[it] = *(const u32x4*)(q_ + 512 + h * 128); vreg[it] = *(const u32x4*)(q_ + 1024 + h * 256 + half * 128); } } \
        if (aact) areg = *(const u32x4*)ap; if (tid < 32) dreg = *(const f32x4*)dp; } while (0)
    GLA_FETCH();
    const LDSC vtr0 = (LDSC)lds + 34816 + ((8 * fq + (fr >> 2)) * QP + 16 * w + 4 * (fr & 3)) * 2;
    const LDSC ktr0 = (LDSC)lds + 17408 + ((8 * fq + (fr >> 2)) * QP + 4 * (fr & 3)) * 2;
    for (int ch = 0; ch < nchunks; ++ch) {
        const size_t rbase = row0 + (size_t)ch * C;
        if (sact) {
#pragma unroll
            for (int it = 0; it < NIT; ++it) { *(u32x4*)(QF + (srow + 32 * it) * QP + sch * 8) = qreg[it]; *(u32x4*)(KTL + (srow + 32 * it) * QP + sch * 8) = kreg[it]; *(u32x4*)(VS + (srow + 32 * it) * QP + sch * 8) = vreg[it]; }
        }
        if (aact) *(u32x4*)(ATT + arow * PT + ach * 8) = areg;
        if (tid < 32) *(f32x4*)(DEC + 4 * tid) = dreg;
        __syncthreads();
        if (ch + 1 < nchunks) { hp += (size_t)C * H1W; ap += (size_t)C * 256; dp += 4 * 128; GLA_FETCH(); }
        bf16x8 vf[CP / 32];
#pragma unroll
        for (int s = 0; s < CP / 32; ++s) { const s16x4 lo = tr_read(vtr0 + (32 * s) * QP * 2), hi = tr_read(vtr0 + (32 * s + 4) * QP * 2); vf[s] = __builtin_shufflevector(lo, hi, 0, 1, 2, 3, 4, 5, 6, 7); }
        bf16x8 sf[4];
#pragma unroll
        for (int s = 0; s < 4; ++s) sf[s] = pack8(S[2 * s], S[2 * s + 1]);
#pragma unroll
        for (int ti = 0; ti < NT; ++ti) {
            f32x4 o = {0.f, 0.f, 0.f, 0.f};
#pragma unroll
            for (int s = 0; s < 4; ++s) { const s16x4 lo = *(const s16x4*)(QF + (16 * ti + fr) * QP + 32 * s + 4 * fq), hi = *(const s16x4*)(QF + (16 * ti + fr) * QP + 32 * s + 16 + 4 * fq);
                const bf16x8 a = __builtin_shufflevector(lo, hi, 0, 1, 2, 3, 4, 5, 6, 7); o = MFMA16(a, sf[s], o); }
#pragma unroll
            for (int s = 0; s < CP / 32; ++s) { const bf16x8 a = *(const bf16x8*)(ATT + (16 * ti + fr) * PT + 32 * s + 8 * fq); o = MFMA16(a, vf[s], o); }
#pragma unroll
            for (int r = 0; r < 4; ++r) OG[(rbase + 16 * ti + 4 * fq + r) * DM + h * 256 + vcol] = (bf16_t)(cvtpk(o[r], 0.f) & 0xffffu);
        }
#pragma unroll
        for (int t = 0; t < 8; ++t) {
            const f32x4 dec = *(const f32x4*)(DEC + 16 * t + 4 * fq);
            S[t] = S[t] * dec;
#pragma unroll
            for (int s = 0; s < CP / 32; ++s) { const s16x4 lo = tr_read(ktr0 + ((32 * s) * QP + 16 * t) * 2), hi = tr_read(ktr0 + ((32 * s + 4) * QP + 16 * t) * 2);
                const bf16x8 a = __builtin_shufflevector(lo, hi, 0, 1, 2, 3, 4, 5, 6, 7); S[t] = MFMA16(a, vf[s], S[t]); }
        }
        __syncthreads();
    }
#undef GLA_FETCH
#pragma unroll
    for (int t = 0; t < 8; ++t)
#pragma unroll
        for (int r = 0; r < 4; ++r) S_out[(size_t)(16 * t + 4 * fq + r) * 256 + vcol] = S[t][r];
}

typedef float f32x16 __attribute__((ext_vector_type(16)));
#define MFMA32(a, b, c) __builtin_amdgcn_mfma_f32_32x32x16_bf16((a), (b), (c), 0, 0, 0)
DI int crow32(int i, int h) { return (i & 3) + 8 * (i >> 2) + 4 * h; }
DI void attn_unit(unsigned char* lds, const bf16_t* Qp, const bf16_t* Kp, const bf16_t* Vp, bf16_t* Op, int nt_lo, int nt_hi, int kv_len, int nvalid,
                  float lam, const float* gn) {
    constexpr int KP = 136, VP = 72;
    const int tid = threadIdx.x, lane = tid & 63, w = __builtin_amdgcn_readfirstlane(tid >> 6), r = lane & 31, h = lane >> 5;
    const int qt = w & 3, map = w >> 2;
    bf16_t* KS = (bf16_t*)lds;
    bf16_t* VT = (bf16_t*)(lds + 17408);
    float* XCH = (float*)(lds + 36864);
    const bool wact = (qt * 32) < nvalid;
    const int my_nt = (qt < 2) ? nt_lo : nt_hi;
    const int qrow = qt * 32 + r;
    const LDSC vtr0 = (LDSC)lds + 17408 + ((4 * h + ((lane & 15) >> 2)) * KP + 16 * ((lane >> 4) & 1) + 4 * (lane & 3)) * 2;
    bf16x8 qf[4];
#pragma unroll
    for (int s = 0; s < 4; ++s) qf[s] = (wact && qrow < nvalid) ? *(const bf16x8*)(Qp + (size_t)qrow * DM + map * 64 + 16 * s + 8 * h) : (bf16x8){0, 0, 0, 0, 0, 0, 0, 0};
    f32x16 O[4];
#pragma unroll
    for (int n = 0; n < 4; ++n)
#pragma unroll
        for (int i = 0; i < 16; ++i) O[n][i] = 0.f;
    float mref = -INFINITY, lsum = 0.f;
    u32x4 kreg[2], vreg[2];
    const int kkey = tid >> 4, kch = tid & 15;
    const bf16_t* kptr = Kp + (size_t)kkey * DM + kch * 8;
    const bf16_t* vptr = Vp + (size_t)kkey * DM + kch * 8;
#pragma unroll
    for (int it = 0; it < 2; ++it) { kreg[it] = *(const u32x4*)(kptr + (size_t)it * 32 * DM); vreg[it] = *(const u32x4*)(vptr + (size_t)it * 32 * DM); }
    __syncthreads();
    for (int t = 0; t < nt_hi; ++t) {
#pragma unroll
        for (int it = 0; it < 2; ++it) { *(u32x4*)(KS + (kkey + 32 * it) * KP + kch * 8) = kreg[it]; *(u32x4*)(VT + (kkey + 32 * it) * KP + kch * 8) = vreg[it]; }
        __syncthreads();
        if (t + 1 < nt_hi) {
            kptr += (size_t)64 * DM; vptr += (size_t)64 * DM;
#pragma unroll
            for (int it = 0; it < 2; ++it) { kreg[it] = *(const u32x4*)(kptr + (size_t)it * 32 * DM); vreg[it] = *(const u32x4*)(vptr + (size_t)it * 32 * DM); }
        }
        if (wact && t < my_nt) {
            f32x16 Sx[2];
#pragma unroll
            for (int kt = 0; kt < 2; ++kt) {
                f32x16 a;
#pragma unroll
                for (int i = 0; i < 16; ++i) a[i] = 0.f;
#pragma unroll
                for (int s = 0; s < 4; ++s) { const bf16x8 kf = *(const bf16x8*)(KS + (32 * kt + r) * KP + map * 64 + 16 * s + 8 * h); a = MFMA32(kf, qf[s], a); }
                Sx[kt] = a;
            }
            const int key0 = t * 64;
            if (key0 + 64 > kv_len) {
#pragma unroll
                for (int kt = 0; kt < 2; ++kt)
#pragma unroll
                    for (int i = 0; i < 16; ++i) if (key0 + 32 * kt + crow32(i, h) >= kv_len) Sx[kt][i] = -INFINITY;
            }
            float mx = -INFINITY;
#pragma unroll
            for (int kt = 0; kt < 2; ++kt)
#pragma unroll
                for (int i = 0; i < 16; ++i) mx = fmaxf(mx, Sx[kt][i]);
            mx = fmaxf(mx, __shfl_xor(mx, 32));
            if (__any(mx > mref + 8.f)) {
                const float mnew = fmaxf(mref, mx); const float corr = __builtin_amdgcn_exp2f(mref - mnew); mref = mnew; lsum *= corr;
#pragma unroll
                for (int n = 0; n < 4; ++n) O[n] = O[n] * corr;
            }
            float ps = 0.f;
#pragma unroll
            for (int kt = 0; kt < 2; ++kt)
#pragma unroll
                for (int i = 0; i < 16; ++i) { const float pv = __builtin_amdgcn_exp2f(Sx[kt][i] - mref); Sx[kt][i] = pv; ps += pv; }
            lsum += ps;
            bf16x8 pf[4];
#pragma unroll
            for (int sp = 0; sp < 4; ++sp) { const int kt = sp >> 1, b8 = 8 * (sp & 1); u32x4 pk;
                pk.x = cvtpk(Sx[kt][b8], Sx[kt][b8 + 1]); pk.y = cvtpk(Sx[kt][b8 + 2], Sx[kt][b8 + 3]); pk.z = cvtpk(Sx[kt][b8 + 4], Sx[kt][b8 + 5]); pk.w = cvtpk(Sx[kt][b8 + 6], Sx[kt][b8 + 7]);
                pf[sp] = __builtin_bit_cast(bf16x8, pk); }
#pragma unroll
            for (int n = 0; n < 4; ++n)
#pragma unroll
                for (int sp = 0; sp < 4; ++sp) {
                    const s16x4 lo = tr_read(vtr0 + ((16 * sp) * KP + 32 * n) * 2), hi = tr_read(vtr0 + ((16 * sp + 8) * KP + 32 * n) * 2);
                    const bf16x8 vf = __builtin_shufflevector(lo, hi, 0, 1, 2, 3, 4, 5, 6, 7);
                    O[n] = MFMA32(vf, pf[sp], O[n]);
                }
        }
        __syncthreads();
    }
    lsum += __shfl_xor(lsum, 32);
    if (map == 1 && wact) {
        const float sc = lam / lsum;
#pragma unroll
        for (int n = 0; n < 4; ++n)
#pragma unroll
            for (int g = 0; g < 4; ++g) { f32x4 v; v[0] = O[n][4 * g] * sc; v[1] = O[n][4 * g + 1] * sc; v[2] = O[n][4 * g + 2] * sc; v[3] = O[n][4 * g + 3] * sc;
                *(f32x4*)(XCH + (size_t)((qt * 16 + n * 4 + g) * 64 + lane) * 4) = v; }
    }
    __syncthreads();
    if (map == 0 && wact) {
        const float inv = 1.f / lsum; float ss = 0.f;
#pragma unroll
        for (int n = 0; n < 4; ++n)
#pragma unroll
            for (int g = 0; g < 4; ++g) { const f32x4 x = *(const f32x4*)(XCH + (size_t)((qt * 16 + n * 4 + g) * 64 + lane) * 4);
#pragma unroll
                for (int j = 0; j < 4; ++j) { const float o = O[n][4 * g + j] * inv - x[j]; O[n][4 * g + j] = o; ss += o * o; } }
        ss += __shfl_xor(ss, 32);
        const float rstd = (1.f - LAMBDA_INIT) / sqrtf(ss * (1.f / 128.f) + RMS_EPS);
        if (qrow < nvalid) {
#pragma unroll
            for (int n = 0; n < 4; ++n)
#pragma unroll
                for (int g = 0; g < 4; ++g) { const int dv0 = 32 * n + 8 * g + 4 * h; const f32x4 gv = *(const f32x4*)(gn + dv0);
                    u32x2 wv; wv.x = cvtpk(O[n][4 * g] * gv[0] * rstd, O[n][4 * g + 1] * gv[1] * rstd); wv.y = cvtpk(O[n][4 * g + 2] * gv[2] * rstd, O[n][4 * g + 3] * gv[3] * rstd);
                    *(u32x2*)(Op + (size_t)qrow * DM + dv0) = wv; }
        }
    }
}

#define LAS __attribute__((address_space(3)))
#define XB_TMO      128
#define XB_XCNT(j)  (256  + 64 * (j))
#define XB_XSUB(j)  (1280 + 64 * (j))
#define XB_XGEN(j)  (2304 + 64 * (j))
#define XB_TOP      3328
#define XB_TOPGEN   3392
#define XCD_BAR_WORDS 3456
#define XB_SPIN_CAP (1u << 18)

__device__ __forceinline__ unsigned xb_ld(unsigned* p)              { return __hip_atomic_load(p, __ATOMIC_RELAXED, __HIP_MEMORY_SCOPE_AGENT); }
__device__ __forceinline__ unsigned xb_add(unsigned* p, unsigned v) { return __hip_atomic_fetch_add(p, v, __ATOMIC_RELAXED, __HIP_MEMORY_SCOPE_AGENT); }
__device__ __forceinline__ unsigned xb_xcc_id() { return (unsigned)__builtin_amdgcn_s_getreg((3 << 11) | 20) & 0xFu; }
#define XB_SPIN(cond, bar) do { unsigned _sp = 0; while (cond) { __builtin_amdgcn_s_sleep(1); \
    if ((++_sp & 255u) == 0u) { if (xb_ld(&(bar)[XB_TMO])) break; if (_sp > XB_SPIN_CAP) { atomicAdd(&(bar)[XB_TMO], 1u); break; } } } } while (0)

struct XcdBarrier {
    unsigned* bar; unsigned x;
    volatile LAS unsigned* st;
};

__device__ __forceinline__ XcdBarrier xcd_barrier_post(unsigned* bar, volatile LAS unsigned* st) {
    XcdBarrier b; b.bar = bar; b.x = xb_xcc_id(); b.st = st;
    if (threadIdx.x == 0) (void)xb_add(&bar[XB_XCNT(b.x)], 1u);
    return b;
}
__device__ __forceinline__ void xcd_barrier_complete(unsigned* bar, unsigned x, unsigned& nloc, unsigned& nx) {
    const unsigned G = gridDim.x * gridDim.y * gridDim.z;
    unsigned sum, cnt, mine, sp = 0u;
    for (;;) {
        sum = 0u; cnt = 0u; mine = 0u;
#pragma unroll
        for (unsigned j = 0; j < 16; ++j) { const unsigned c = xb_ld(&bar[XB_XCNT(j)]); sum += c; cnt += (c > 0u) ? 1u : 0u; mine = (j == x) ? c : mine; }
        if (sum == G) break;
        __builtin_amdgcn_s_sleep(1);
        if ((++sp & 255u) == 0u) { if (xb_ld(&bar[XB_TMO])) break; if (sp > XB_SPIN_CAP) { atomicAdd(&bar[XB_TMO], 1u); break; } }
    }
    nloc = mine > 0u ? mine : 1u; nx = cnt > 0u ? cnt : 1u;
}

__device__ __forceinline__ void xcd_barrier(const XcdBarrier& b) {
    asm volatile("s_waitcnt vmcnt(0)" ::: "memory");
    __syncthreads();
    if (threadIdx.x == 0) {
        unsigned* bar = b.bar;
        __builtin_amdgcn_s_waitcnt(0);
        unsigned nloc = b.st[0], nx = b.st[1];
        if (nloc == 0u) { xcd_barrier_complete(bar, b.x, nloc, nx); b.st[0] = nloc; b.st[1] = nx; }
        const unsigned old = xb_add(&bar[XB_XSUB(b.x)], 1u);
        const unsigned gen = old / nloc;
        if (old + 1u == (gen + 1u) * nloc) {
            __builtin_amdgcn_fence(__ATOMIC_RELEASE, "agent");
            asm volatile("s_waitcnt vmcnt(0)" ::: "memory");
            const unsigned og = xb_add(&bar[XB_TOP], 1u);
            const unsigned tg = og / nx;
            if (og + 1u == (tg + 1u) * nx) xb_add(&bar[XB_TOPGEN], 1u);
            else XB_SPIN(xb_ld(&bar[XB_TOPGEN]) == tg, bar);
            __builtin_amdgcn_fence(__ATOMIC_ACQUIRE, "agent");
            xb_add(&bar[XB_XGEN(b.x)], 1u);
            asm volatile("s_waitcnt vmcnt(0)" ::: "memory");
        } else {
            XB_SPIN(xb_ld(&bar[XB_XGEN(b.x)]) == gen, bar);
            __builtin_amdgcn_fence(__ATOMIC_ACQUIRE, "agent");
            asm volatile("s_waitcnt vmcnt(0)" ::: "memory");
        }
    }
    __syncthreads();
}

constexpr int NPHASE = 16;
__global__ void __launch_bounds__(NTHREADS) yoco_fwd(Params p) {
    extern __shared__ __attribute__((aligned(16))) unsigned char lds[];
    cg::grid_group grid = cg::this_grid();
    const int tid = threadIdx.x, lane = tid & 63, wave = __builtin_amdgcn_readfirstlane(tid >> 6);
    const int G = gridDim.x, bx = blockIdx.x;
    const int gw = bx * NWAVES + wave, ngw = G * NWAVES;
    unsigned char* ws = p.ws;
    bf16_t* XB = (bf16_t*)(ws + WS_XB);
    float* XR = p.out;
    float* GL = (float*)(ws + WS_GL);
    float* STATS = (float*)(ws + WS_STATS);
    bf16_t* ATTg = (bf16_t*)(ws + WS_ATTG);
    float* DECg = (float*)(ws + WS_DECG);
    float* PART = (float*)(ws + WS_PART);
    bf16_t* H1 = (bf16_t*)(ws + WS_BIG + BIG_H1);
    bf16_t* OG = (bf16_t*)(ws + WS_BIG + BIG_OG);
    bf16_t* U = (bf16_t*)(ws + WS_BIG + BIG_U);
    bf16_t* KB = (bf16_t*)(ws + WS_BIG + BIG_KB);
    bf16_t* VB = (bf16_t*)(ws + WS_BIG + BIG_VB);
    bf16_t* QB = (bf16_t*)(ws + WS_BIG + BIG_QB);
    bf16_t* OB = (bf16_t*)(ws + WS_BIG + BIG_OB);
    bf16_t* KSb = (bf16_t*)(ws + WS_KS);
    bf16_t* VSb = (bf16_t*)(ws + WS_VS);
    if (tid < 2) ((volatile LAS unsigned*)((LAS unsigned char*)lds + (LDS_BYTES - 16)))[tid] = 0u;
    __syncthreads();
    XcdBarrier xbar = xcd_barrier_post((unsigned*)(ws + WS_CTL), (volatile LAS unsigned*)((LAS unsigned char*)lds + (LDS_BYTES - 16)));
    const int lo = p.ph_lo, hi = p.ph_hi;
#define IN(k) (lo <= (k) && (k) < hi)
#define SEAM(k) do { if (IN(k) && IN((k) + 1)) { if ((k) == 0) grid.sync(); else xcd_barrier(xbar); } } while (0)
#define LDSP ((PG8_LAS unsigned char*)lds)
#ifndef PROBE_DUP
#define PROBE_DUP -1
#endif
#define REPS(k) ((PROBE_DUP == (k)) ? 2 : 1)
#define PH(k) if (IN(k)) for (int rep_ = 0; rep_ < REPS(k); ++rep_, (rep_ < REPS(k) ? grid.sync() : (void)0))

    PH(0) { phase_prep(p, lds, gw, ngw, wave, lane); }
    SEAM(0);
    PH(1) { pg8::Gemm g{XB, (const bf16_t*)(ws + WS_WIN), NROWS, NWIN, 1024}; pg8::MixOrder S; S.init(NWIN, 1024, 1, G, bx); EpiH1 E{H1, GL};
        pg8::gemm_phase<EpiH1, pg8::MixOrder, true, true>(LDSP, g, S, E); }
    SEAM(1);
    PH(2) {
        for (int u = bx; u < 4096 + 128; u += G) {
            if (u < 4096) { const int h = u & 3, cid = u >> 2; gla_pre<64>(lds, H1, GL, ATTg, DECg, (size_t)cid * 64, cid, h, p.in[6], p.in[7]); }
            else { const int v = u - 4096, h = v & 3, b = v >> 2; gla_pre<16>(lds, H1, GL, ATTg, DECg, (size_t)NPROMPT + (size_t)b * DEC_SEQ, 1024 + b, h, p.in[6], p.in[7]); }
        }
        xcd_barrier(xbar);
        for (int u = bx; u < 512; u += G) {
            if (u < 256) { const int b = u >> 3, h = (u >> 1) & 3, half = u & 1;
                gla_seq<64>(lds, H1, ATTg, DECg, OG, (size_t)b * SEQ, SEQ / 64, b * 32, h, half, nullptr, p.out + OUT_SP + (size_t)(b * 4 + h) * 128 * 256); }
            else { const int v = u - 256, b = v >> 3, h = (v >> 1) & 3, half = v & 1;
                gla_seq<16>(lds, H1, ATTg, DECg, OG, (size_t)NPROMPT + (size_t)b * DEC_SEQ, 1, 1024 + b, h, half, p.in[2] + (size_t)(b * 4 + h) * 128 * 256, p.out + OUT_SS + (size_t)(b * 4 + h) * 128 * 256); }
        }
    }
    SEAM(2);
    PH(3) { phase_ognorm(OG, H1, p.in[8], gw, ngw, lane); }
    SEAM(3);
    PH(4) { pg8::Gemm g{OG, (const bf16_t*)(ws + WS_WOA), NROWS, 1024, 1024}; pg8::MixOrder S; S.init(1024, 1024, 4, G, bx); EpiRes E{XR, p.in[0], p.in[1], STATS, nullptr, nullptr, PART, 0};
        pg8::gemm_phase<EpiRes, pg8::MixOrder, true, true>(LDSP, g, S, E); }
    SEAM(4);
    PH(5) { phase_ln(XR, XB, STATS, PART, 3, p.in[17], p.in[18], false, gw, ngw, lane); }
    SEAM(5);
    PH(6) { pg8::Gemm g{XB, (const bf16_t*)(ws + WS_WUP0), NROWS, DFF, 1024}; pg8::MixOrder S; S.init(DFF, 1024, 1, G, bx); EpiUp E{U};
        pg8::gemm_phase<EpiUp, pg8::MixOrder, true, true>(LDSP, g, S, E); }
    SEAM(6);
    PH(7) { pg8::Gemm g{U, (const bf16_t*)(ws + WS_WDN0), NROWS, 1024, DFF}; pg8::MixOrder S; S.init(1024, DFF, 16, G, bx); EpiRes E{XR, nullptr, nullptr, STATS, p.in[17], p.in[18], PART, 1};
        pg8::gemm_phase<EpiRes, pg8::MixOrder, true, true>(LDSP, g, S, E); }
    SEAM(7);
    PH(8) { phase_ln(XR, XB, STATS, PART, 15, p.in[17] + 1024, p.in[18] + 1024, false, gw, ngw, lane); }
    SEAM(8);
    PH(9) { pg8::Gemm g{XB, (const bf16_t*)(ws + WS_WKVQ), NROWS, 3072, 1024}; pg8::MixOrder S; S.init(3072, 1024, 1, G, bx);
        EpiKVQ E{p.out, KB, VB, QB, KSb, VSb, (const float*)(ws + WS_ROPE)};
        pg8::gemm_phase<EpiKVQ, pg8::MixOrder, true, true>(LDSP, g, S, E); }
    SEAM(9);
    PH(10) {
        const float* lm = p.in[12];
        const float d1 = wave_sum(lm[lane] * lm[64 + lane]), d2 = wave_sum(lm[128 + lane] * lm[192 + lane]);
        const float lam = __expf(d1) - __expf(d2) + LAMBDA_INIT;
        if (G == 256) {
            const int vcu = (bx & 7) * 32 + (bx >> 3), xcd = vcu >> 5, local = vcu & 31, sub = local >> 3, sx = local & 7;
            for (int rd = 0; rd < 8; ++rd) {
                const int u = xcd * 32 + rd * 4 + sub, b = u >> 3, h = u & 7;
                for (int q = 0; q < 2; ++q) {
                    const int i = q ? sx : 15 - sx;
                    const size_t qrow = (size_t)b * SEQ + 128 * i;
                    attn_unit(lds, QB + qrow * DM + h * 128, KB + (size_t)b * SEQ * DM + h * 128, VB + (size_t)b * SEQ * DM + h * 128, OB + qrow * DM + h * 128,
                              2 * i + 1, 2 * i + 2, 1 << 30, 128, lam, p.in[13]);
                }
            }
        } else {
            for (int u = bx; u < 256; u += G) {
                const int b = u >> 3, h = u & 7;
                for (int i = 15; i >= 0; --i) {
                    const size_t qrow = (size_t)b * SEQ + 128 * i;
                    attn_unit(lds, QB + qrow * DM + h * 128, KB + (size_t)b * SEQ * DM + h * 128, VB + (size_t)b * SEQ * DM + h * 128, OB + qrow * DM + h * 128,
                              2 * i + 1, 2 * i + 2, 1 << 30, 128, lam, p.in[13]);
                }
            }
        }
        for (int u = bx; u < 256; u += G) {
            const int b = u >> 3, h = u & 7;
            const size_t qrow = (size_t)NPROMPT + (size_t)b * DEC_SEQ;
            attn_unit(lds, QB + qrow * DM + h * 128, KSb + (size_t)b * KVS_ROWS * DM + h * 128, VSb + (size_t)b * KVS_ROWS * DM + h * 128, OB + qrow * DM + h * 128,
                      17, 17, PAST + DEC_SEQ, DEC_SEQ, lam, p.in[13]);
        }
    }
    SEAM(10);
    PH(11) { pg8::Gemm g{OB, (const bf16_t*)(ws + WS_WOB), NROWS, 1024, 1024}; pg8::MixOrder S; S.init(1024, 1024, 4, G, bx); EpiRes E{XR, nullptr, nullptr, STATS, p.in[17] + 1024, p.in[18] + 1024, PART, 1};
        pg8::gemm_phase<EpiRes, pg8::MixOrder, true, true>(LDSP, g, S, E); }
    SEAM(11);
    PH(12) { phase_ln(XR, XB, STATS, PART, 3, p.in[17] + 2048, p.in[18] + 2048, false, gw, ngw, lane); }
    SEAM(12);
    PH(13) { pg8::Gemm g{XB, (const bf16_t*)(ws + WS_WUP1), NROWS, DFF, 1024}; pg8::MixOrder S; S.init(DFF, 1024, 1, G, bx); EpiUp E{U};
        pg8::gemm_phase<EpiUp, pg8::MixOrder, true, true>(LDSP, g, S, E); }
    SEAM(13);
    PH(14) { pg8::Gemm g{U, (const bf16_t*)(ws + WS_WDN1), NROWS, 1024, DFF}; pg8::MixOrder S; S.init(1024, DFF, 16, G, bx); EpiRes E{XR, nullptr, nullptr, STATS, p.in[17] + 2048, p.in[18] + 2048, PART, 1};
        pg8::gemm_phase<EpiRes, pg8::MixOrder, true, true>(LDSP, g, S, E); }
    SEAM(14);
    PH(15) { phase_ln(XR, nullptr, STATS, PART, 15, p.in[17] + 3072, p.in[18] + 3072, true, gw, ngw, lane); }
#undef IN
#undef SEAM
}

#ifndef ONE_LAUNCH
#define ONE_LAUNCH 1
#endif
extern "C" void kernel_launch(void* const* d_in, const int* in_sizes, int n_in, void* d_out, int out_size, void* d_ws, size_t ws_size, hipStream_t stream) {
    static int grid = 0;
    if (grid == 0) {
        if (n_in != 19 || ws_size < WS_END) { fprintf(stderr, "kernel_launch: unexpected n_in %d / ws_size %zu (need %zu)\n", n_in, ws_size, (size_t)WS_END); grid = -1; return; }
        int dev = 0, cus = 0, per_cu = 0;
        hipGetDevice(&dev); hipDeviceGetAttribute(&cus, hipDeviceAttributeMultiprocessorCount, dev);
        if (hipFuncSetAttribute((const void*)yoco_fwd, hipFuncAttributeMaxDynamicSharedMemorySize, LDS_BYTES) != hipSuccess) { fprintf(stderr, "kernel_launch: hipFuncSetAttribute failed\n"); grid = -1; return; }
        if (hipOccupancyMaxActiveBlocksPerMultiprocessor(&per_cu, (const void*)yoco_fwd, NTHREADS, LDS_BYTES) != hipSuccess || per_cu < 1) { fprintf(stderr, "kernel_launch: occupancy query says %d\n", per_cu); per_cu = 1; }
        (void)hipGetLastError();
        grid = cus * 1;
        if (grid <= 0) grid = 256;
    }
    if (grid < 0) return;
    Params p{};
    for (int i = 0; i < 19; ++i) p.in[i] = (const float*)d_in[i];
    p.out = (float*)d_out; p.ws = (unsigned char*)d_ws;
#if ONE_LAUNCH
    if (hipMemsetAsync((char*)d_ws + WS_CTL, 0, CTL_BYTES, stream) != hipSuccess) { fprintf(stderr, "kernel_launch: memset of barrier words failed\n"); return; }
    p.ph_lo = 0; p.ph_hi = NPHASE;
    void* args[] = {&p};
    hipError_t e = hipLaunchCooperativeKernel((const void*)yoco_fwd, dim3(grid), dim3(NTHREADS), args, LDS_BYTES, stream);
    if (e != hipSuccess) fprintf(stderr, "cooperative launch failed: %s (grid %d)\n", hipGetErrorString(e), grid);
#else
    for (int ph = 0; ph < NPHASE; ++ph) {
        p.ph_lo = ph; p.ph_hi = ph + 1;
        hipLaunchKernelGGL(yoco_fwd, dim3(grid), dim3(NTHREADS), LDS_BYTES, stream, p);
    }
#endif
}
```

```cpp
#include <hip/hip_runtime.h>
#include <hip/hip_cooperative_groups.h>
#include <cstdio>
#include <cstdint>
#include <cmath>
namespace cg = cooperative_groups;
namespace pg8 {
#define PG8_LAS __attribute__((address_space(3)))
typedef unsigned short bf16_t;
typedef short bf16x8 __attribute__((ext_vector_type(8)));
typedef float f32x4 __attribute__((ext_vector_type(4)));
typedef unsigned u32x4 __attribute__((ext_vector_type(4)));
constexpr int BM = 256, BK = 64, HALF = 128, HTB = HALF * BK * 2  , STAGE_BYTES = 8 * HTB, NXCD = 8, WGM = 8;

__host__ __device__ __forceinline__ int lds_byte(int r, int c) { const int st = (r >> 4) * 2 + (c >> 5), rr = r & 15, cc = c & 31, ob = rr * 64 + cc * 2; return st * 1024 + (ob ^ (((ob >> 9) & 1) << 5)); }
__host__ __device__ __forceinline__ void stage_rc(int b, int& R, int& C) { const int st = b / 1024, sb = b % 1024, swz = sb ^ (((sb >> 9) & 1) << 5); R = (st >> 1) * 16 + swz / 64; C = (st & 1) * 32 + (swz % 64) / 2; }
__host__ __device__ __forceinline__ int perm32(int rho) { const int n = rho >> 4, i = rho & 15; return 8 * (i >> 2) + 4 * n + (i & 3); }

struct Unit { int pm, pn, ks, nt; };
struct Gemm { const bf16_t* A; const bf16_t* Bt; int M, N, K; };

struct StaticOrder {
    int nM, nN, nwg, G, c;
    __host__ __device__ void init(int M, int N, int G_, int c_) { nM = M / BM; nN = N / BM; nwg = nM * nN; G = G_; c = c_; }
    __host__ __device__ bool next(int i, Unit& u) const {
        const long L = (long)i * G + c; if (L >= nwg) return false;
        int wgid = (int)L; { const int q = nwg / NXCD, r = nwg % NXCD, xcd = wgid % NXCD, off = wgid / NXCD; wgid = (xcd < r ? xcd * (q + 1) : r * (q + 1) + (xcd - r) * q) + off; }
        const int nig = WGM * nN, gid = wgid / nig, fm = gid * WGM, gsz = (nM - fm) < WGM ? (nM - fm) : WGM;
        u.pm = fm + ((wgid % nig) % gsz); u.pn = (wgid % nig) / gsz; return true;
    }
    __device__ __forceinline__ void a_ready(const Unit&) const {}
    __device__ __forceinline__ void done(const Unit&) const {}
};

struct MixOrder {
    StaticOrder so; int nmain, nN, S, ntm, nts, G, c;
    __device__ void init(int N, int Kext, int S_, int G_, int c_) { so.init(65536, N, G_, c_); nmain = so.nwg; nN = N / BM; S = S_; ntm = Kext / BK; nts = Kext / BK / S_; G = G_; c = c_; }
    __device__ bool next(int i, Unit& u) const {
        const long L = (long)i * G + c;
        if (L < nmain) { so.next(i, u); u.ks = 0; u.nt = ntm; return true; }
        const int e = (int)(L - nmain); if (e >= 2 * nN * S) return false;
        u.pn = e % nN; const int rest = e / nN; u.pm = 256 + (rest & 1); u.ks = rest >> 1; u.nt = nts; return true;
    }
    __device__ __forceinline__ void a_ready(const Unit&) const {}
    __device__ __forceinline__ void done(const Unit&) const {}
};
typedef float f32x2 __attribute__((ext_vector_type(2)));
template <class Epi, class Sched, bool ALIGN_EPI = false, bool SP2 = false>
__device__ __forceinline__ void gemm_phase(PG8_LAS unsigned char* lds, const Gemm g, const Sched& S, const Epi& E) {
    const int tid = threadIdx.x, wid = __builtin_amdgcn_readfirstlane(tid >> 6), lane = tid & 63, wr = wid >> 2, wc = wid & 3, fr = lane & 15, fq = lane >> 4;
    const int K = g.K;
    unsigned voffA[2], voffB[2];
#pragma unroll
    for (int i = 0; i < 2; ++i) { int R, C; stage_rc(tid * 16 + i * 8192, R, C); const int Rb = Epi::PERM ? ((R & ~31) + perm32(R & 31)) : R;
        voffA[i] = (unsigned)(R * K + C) * 2u; voffB[i] = (unsigned)(Rb * K + C) * 2u; }
    const size_t kstep = (size_t)(BK * 2);
    const size_t hstep = (size_t)HALF * K * 2;
    const size_t tstep = 2 * hstep;
    const unsigned ldsw = (unsigned)wid * 1024u;
    const int aoff = lds_byte(wr * 64 + fr, fq * 8), boff = lds_byte(wc * 32 + fr, fq * 8);
#define PG8_SA(b, h) (((b) * 2 + (h)) * HTB)
#define PG8_SB(b, h) ((4 + (b) * 2 + (h)) * HTB)
#define PG8_STAGE(bufoff, gbase, voff) do { _Pragma("unroll") for (int _i = 0; _i < 2; ++_i) \
        __builtin_amdgcn_global_load_lds((const unsigned*)((const char*)(gbase) + (voff)[_i]), (PG8_LAS unsigned*)(lds + (bufoff) + ldsw + _i * 8192), 16, 0, 0); } while (0)
#define PG8_LDA(dst, b, h) do { _Pragma("unroll") for (int m = 0; m < 4; ++m) _Pragma("unroll") for (int k = 0; k < 2; ++k) dst[m][k] = *(const PG8_LAS bf16x8*)(lds + PG8_SA(b, h) + aoff + m * 2048 + k * 1024); } while (0)
#define PG8_LDB(dst, b, h) do { _Pragma("unroll") for (int n = 0; n < 2; ++n) _Pragma("unroll") for (int k = 0; k < 2; ++k) dst[n][k] = *(const PG8_LAS bf16x8*)(lds + PG8_SB(b, h) + boff + n * 2048 + k * 1024); } while (0)
#define PG8_MMA(ai, bj, At, Bt) do { __builtin_amdgcn_s_setprio(1); _Pragma("unroll") for (int m = 0; m < 4; ++m) _Pragma("unroll") for (int n = 0; n < 2; ++n) _Pragma("unroll") for (int k = 0; k < 2; ++k) \
        acc[ai][bj][m][n] = __builtin_amdgcn_mfma_f32_16x16x32_bf16(Bt[n][k], At[m][k], acc[ai][bj][m][n], 0, 0, 0); __builtin_amdgcn_s_setprio(0); } while (0)
#define PG8_WAIT_V(n) asm volatile("s_waitcnt vmcnt(" #n ")" ::: "memory")
#define PG8_WAIT_L(n) asm volatile("s_waitcnt lgkmcnt(" #n ")" ::: "memory")
#define PG8_BAR __builtin_amdgcn_s_barrier()
#define PG8_SCHED __builtin_amdgcn_sched_barrier(0)
    Unit cur, nxt; int ui = 0;
    if (!S.next(0, cur)) return;
    f32x4 acc[2][2][4][2];
#pragma unroll
    for (int a = 0; a < 2; ++a)
#pragma unroll
        for (int b = 0; b < 2; ++b)
#pragma unroll
            for (int m = 0; m < 4; ++m)
#pragma unroll
                for (int n = 0; n < 2; ++n) acc[a][b][m][n] = (f32x4){0.f, 0.f, 0.f, 0.f};
    bf16x8 At[4][2], B0[2][2], B1[2][2];
    const char* cA = (const char*)g.A + (size_t)cur.pm * tstep + (size_t)cur.ks * cur.nt * (BK * 2); const char* cB = (const char*)g.Bt + (size_t)cur.pn * tstep + (size_t)cur.ks * cur.nt * (BK * 2);
    S.a_ready(cur);
    if constexpr (SP2) {
        PG8_STAGE(PG8_SB(0, 0), cB, voffB); PG8_STAGE(PG8_SB(0, 1), cB + hstep, voffB); PG8_STAGE(PG8_SA(0, 0), cA, voffA); PG8_STAGE(PG8_SA(0, 1), cA + hstep, voffA);
        if (wr == 1) PG8_BAR;
        PG8_WAIT_V(2); PG8_BAR;
        PG8_STAGE(PG8_SB(1, 0), cB + kstep, voffB); PG8_STAGE(PG8_SA(1, 0), cA + kstep, voffA); PG8_STAGE(PG8_SB(1, 1), cB + hstep + kstep, voffB);
        PG8_WAIT_V(6); PG8_BAR;
    } else {
        PG8_STAGE(PG8_SB(0, 0), cB, voffB); PG8_STAGE(PG8_SA(0, 0), cA, voffA); PG8_STAGE(PG8_SB(0, 1), cB + hstep, voffB); PG8_STAGE(PG8_SA(0, 1), cA + hstep, voffA);
        if (wr == 1) PG8_BAR;
        PG8_WAIT_V(4); PG8_BAR;
        PG8_STAGE(PG8_SB(1, 0), cB + kstep, voffB); PG8_STAGE(PG8_SA(1, 0), cA + kstep, voffA); PG8_STAGE(PG8_SB(1, 1), cB + hstep + kstep, voffB);
        PG8_WAIT_V(6); PG8_BAR;
    }
    for (;;) {
        const bool has_next = S.next(ui + 1, nxt);
        const char* nA = has_next ? (const char*)g.A + (size_t)nxt.pm * tstep + (size_t)nxt.ks * nxt.nt * (BK * 2) : cA; const char* nB = has_next ? (const char*)g.Bt + (size_t)nxt.pn * tstep + (size_t)nxt.ks * nxt.nt * (BK * 2) : cB;
        const int nt = cur.nt;
        for (int t = 0; t < nt; t += 2) {
            const bool last = (t == nt - 2);
            const char* a1 = cA + (size_t)(t + 1) * kstep;
            const char* a2 = last ? nA : cA + (size_t)(t + 2) * kstep; const char* b2 = last ? nB : cB + (size_t)(t + 2) * kstep;
            const char* a3 = a2 + kstep; const char* b3 = b2 + kstep;
            if (last && has_next) S.a_ready(nxt);
            if constexpr (SP2) {
            PG8_LDB(B0, 0, 0); PG8_LDB(B1, 0, 1); PG8_SCHED; PG8_LDA(At, 0, 0); PG8_STAGE(PG8_SA(1, 1), a1 + hstep, voffA);
            PG8_WAIT_V(8); PG8_WAIT_L(0); PG8_BAR; PG8_MMA(0, 0, At, B0); PG8_MMA(0, 1, At, B1); PG8_BAR; PG8_SCHED;
            PG8_LDA(At, 0, 1); PG8_STAGE(PG8_SB(0, 0), b2, voffB); PG8_STAGE(PG8_SB(0, 1), b2 + hstep, voffB); PG8_STAGE(PG8_SA(0, 0), a2, voffA);
            PG8_WAIT_V(8); PG8_WAIT_L(0); PG8_BAR; PG8_MMA(1, 0, At, B0); PG8_MMA(1, 1, At, B1); PG8_BAR; PG8_SCHED;
            PG8_LDB(B0, 1, 0); PG8_LDB(B1, 1, 1); PG8_SCHED; PG8_LDA(At, 1, 0); PG8_STAGE(PG8_SA(0, 1), a2 + hstep, voffA);
            PG8_WAIT_V(8); PG8_WAIT_L(0); PG8_BAR; PG8_MMA(0, 0, At, B0); PG8_MMA(0, 1, At, B1); PG8_BAR; PG8_SCHED;
            PG8_LDA(At, 1, 1); PG8_STAGE(PG8_SB(1, 0), b3, voffB); PG8_STAGE(PG8_SB(1, 1), b3 + hstep, voffB); PG8_STAGE(PG8_SA(1, 0), a3, voffA);
            PG8_WAIT_V(8); PG8_WAIT_L(0); PG8_BAR; PG8_MMA(1, 0, At, B0); PG8_MMA(1, 1, At, B1); PG8_BAR; PG8_SCHED;
            } else {
            PG8_LDB(B0, 0, 0); PG8_SCHED; PG8_LDA(At, 0, 0); PG8_STAGE(PG8_SA(1, 1), a1 + hstep, voffA);
            PG8_WAIT_L(8); PG8_BAR; PG8_WAIT_L(0); PG8_MMA(0, 0, At, B0); PG8_BAR; PG8_SCHED;
            PG8_LDB(B1, 0, 1); PG8_STAGE(PG8_SB(0, 0), b2, voffB);
            PG8_BAR; PG8_WAIT_L(0); PG8_MMA(0, 1, At, B1); PG8_BAR;
            PG8_LDA(At, 0, 1); PG8_STAGE(PG8_SA(0, 0), a2, voffA);
            PG8_BAR; PG8_WAIT_L(0); PG8_MMA(1, 0, At, B0); PG8_BAR; PG8_SCHED;
            PG8_STAGE(PG8_SB(0, 1), b2 + hstep, voffB);
            PG8_WAIT_V(6); PG8_BAR; PG8_MMA(1, 1, At, B1); PG8_BAR;
            PG8_LDB(B0, 1, 0); PG8_SCHED; PG8_LDA(At, 1, 0); PG8_STAGE(PG8_SA(0, 1), a2 + hstep, voffA);
            PG8_WAIT_L(8); PG8_BAR; PG8_WAIT_L(0); PG8_MMA(0, 0, At, B0); PG8_BAR; PG8_SCHED;
            PG8_LDB(B1, 1, 1); PG8_STAGE(PG8_SB(1, 0), b3, voffB);
            PG8_BAR; PG8_WAIT_L(0); PG8_MMA(0, 1, At, B1); PG8_BAR;
            PG8_LDA(At, 1, 1); PG8_STAGE(PG8_SA(1, 0), a3, voffA);
            PG8_BAR; PG8_WAIT_L(0); PG8_MMA(1, 0, At, B0); PG8_BAR; PG8_SCHED;
            PG8_STAGE(PG8_SB(1, 1), b3 + hstep, voffB);
            PG8_WAIT_V(6); PG8_BAR; PG8_MMA(1, 1, At, B1); PG8_BAR;
            }
        }
        if constexpr (ALIGN_EPI) { if (wr == 0) PG8_BAR; }
        if constexpr (!Epi::AFTER_DRAIN) { E(acc, cur, wr, wc, fr, fq); S.done(cur); }
        if (!has_next) break;
#pragma unroll
        for (int a = 0; a < 2; ++a)
#pragma unroll
            for (int b = 0; b < 2; ++b)
#pragma unroll
                for (int m = 0; m < 4; ++m)
#pragma unroll
                    for (int n = 0; n < 2; ++n) acc[a][b][m][n] = (f32x4){0.f, 0.f, 0.f, 0.f};
        cur = nxt; cA = nA; cB = nB; ++ui;
        if constexpr (ALIGN_EPI) { if (wr == 1) PG8_BAR; }
    }
    PG8_WAIT_V(0);
    if constexpr (!ALIGN_EPI) { if (wr == 0) PG8_BAR; }
    PG8_BAR;
    if constexpr (Epi::AFTER_DRAIN) { E.fused(acc, cur, wr, wc, fr, fq, lds, wid, lane); S.done(cur); }
#undef PG8_SA
#undef PG8_SB
#undef PG8_STAGE
#undef PG8_LDA
#undef PG8_LDB
#undef PG8_MMA
#undef PG8_WAIT_V
#undef PG8_WAIT_L
#undef PG8_BAR
#undef PG8_SCHED
}
}

typedef unsigned short bf16_t;
typedef short bf16x8 __attribute__((ext_vector_type(8)));
typedef short s16x4 __attribute__((ext_vector_type(4)));
typedef float f32x4 __attribute__((ext_vector_type(4)));
typedef float f32x2v __attribute__((ext_vector_type(2)));
typedef __bf16 bf16x2_t __attribute__((ext_vector_type(2)));
typedef unsigned u32x4 __attribute__((ext_vector_type(4)));
typedef unsigned u32x2 __attribute__((ext_vector_type(2)));

constexpr int DM = 1024;
constexpr int NPROMPT = 32 * 2048;
constexpr int NSAMPLE = 32 * 16;
constexpr int NROWS = NPROMPT + NSAMPLE;
constexpr int SEQ = 2048, DEC_SEQ = 16, PAST = 1024, KVS_ROWS = 1088;
constexpr int H1W = 3072;
constexpr int NWIN = 3328;
constexpr int DFF = 4096;
constexpr float ALPHA = 1.4142135623730951f;
constexpr float LAMBDA_INIT = 0.35550906759096934f;
constexpr float LN_EPS = 1e-5f, RMS_EPS = 1e-5f;
constexpr float QSCALE_B = 0.18033688011112042f;
constexpr float QSCALE_A = 0.08838834764831845f;

constexpr size_t MiB = 1u << 20;
constexpr size_t WS_WIN = 0, WS_WOA = 7 * MiB, WS_WKVQ = 9 * MiB, WS_WOB = 15 * MiB, WS_WUP0 = 17 * MiB, WS_WUP1 = 25 * MiB,
                 WS_WDN0 = 33 * MiB, WS_WDN1 = 41 * MiB, WS_ROPE = 49 * MiB, WS_GL = 50 * MiB, WS_XB = 56 * MiB,
                 WS_KS = 186 * MiB, WS_VS = 254 * MiB, WS_BIG = 322 * MiB;
constexpr size_t BIG_H1 = 0, BIG_OG = (size_t)NROWS * H1W * 2, BIG_U = 0, BIG_KB = 0, BIG_VB = 128 * MiB, BIG_QB = 256 * MiB, BIG_OB = 385 * MiB;
constexpr size_t WS_CTL = 55 * MiB + 768 * 1024, CTL_BYTES = 16384;
constexpr size_t WS_STATS = 55 * MiB, WS_PART = WS_BIG + 516 * MiB;
constexpr size_t WS_ATTG = WS_PART + 30 * MiB, WS_DECG = WS_ATTG + 33 * MiB;
constexpr size_t WS_ZB = WS_PART + 30 * MiB;
constexpr size_t WS_END = WS_ZB + 130 * MiB;
static_assert(BIG_OG + (size_t)NROWS * DM * 2 <= 516 * MiB, "big region");
static_assert(BIG_OB + (size_t)NROWS * DM * 2 <= 516 * MiB, "big region");
static_assert((size_t)NROWS * DFF * 2 <= 516 * MiB, "big region");

constexpr size_t OUT_Y = 0, OUT_SP = 67633152, OUT_KP = 71827456, OUT_VP = 138936320, OUT_SS = 206045184, OUT_KSMP = 210239488, OUT_VSMP = 210763776;

constexpr int NTHREADS = 512, NWAVES = 8;
constexpr int LDS_BYTES = 147456;

#define DI __device__ __forceinline__
DI unsigned cvtpk(float lo, float hi) { f32x2v v = {lo, hi}; bf16x2_t b = __builtin_convertvector(v, bf16x2_t); return __builtin_bit_cast(unsigned, b); }
DI float bf2f(unsigned short h) { return __uint_as_float(((unsigned)h) << 16); }
DI float bflo(unsigned w) { return __uint_as_float(w << 16); }
DI float bfhi(unsigned w) { return __uint_as_float(w & 0xffff0000u); }
DI bf16x8 pack8(f32x4 a, f32x4 b) { u32x4 p; p.x = cvtpk(a[0], a[1]); p.y = cvtpk(a[2], a[3]); p.z = cvtpk(b[0], b[1]); p.w = cvtpk(b[2], b[3]); return __builtin_bit_cast(bf16x8, p); }
#define MFMA16(a, b, c) __builtin_amdgcn_mfma_f32_16x16x32_bf16((a), (b), (c), 0, 0, 0)

struct Params { const float* in[19]; float* out; unsigned char* ws; int ph_lo, ph_hi; };

struct EpiH1 {
    static constexpr bool PERM = true, AFTER_DRAIN = false;
    bf16_t* H1; float* GL;
    DI void operator()(const pg8::f32x4 (&acc)[2][2][4][2], const pg8::Unit& u, int wr, int wc, int fr, int fq) const {
        const int row0 = u.pm * 256 + wr * 64 + fr;
        if (u.pn < 12) {
            const float sc = (u.pn < 2) ? QSCALE_A : 1.0f;
            const int col0 = u.pn * 256 + wc * 32 + 8 * fq;
#pragma unroll
            for (int ai = 0; ai < 2; ++ai)
#pragma unroll
                for (int m = 0; m < 4; ++m) { bf16_t* rowp = H1 + (size_t)(row0 + ai * 128 + m * 16) * H1W + col0;
#pragma unroll
                    for (int bj = 0; bj < 2; ++bj) { f32x4 v0 = acc[ai][bj][m][0] * sc, v1 = acc[ai][bj][m][1] * sc; u32x4 w;
                        w.x = cvtpk(v0[0], v0[1]); w.y = cvtpk(v0[2], v0[3]); w.z = cvtpk(v1[0], v1[1]); w.w = cvtpk(v1[2], v1[3]);
                        *(u32x4*)(rowp + bj * 128) = w; } }
        } else {
            if (wc == 0 && fq < 2) {
#pragma unroll
                for (int ai = 0; ai < 2; ++ai)
#pragma unroll
                    for (int m = 0; m < 4; ++m) { float* rowp = GL + (size_t)(row0 + ai * 128 + m * 16) * 16 + 8 * fq;
                        *(f32x4*)(rowp) = acc[ai][0][m][0]; *(f32x4*)(rowp + 4) = acc[ai][0][m][1]; }
            }
        }
    }
};
struct EpiRes {
    static constexpr bool PERM = true, AFTER_DRAIN = false;
    bf16_t* Zb; const bf16_t* XBr; float* part;
    DI void operator()(const pg8::f32x4 (&acc)[2][2][4][2], const pg8::Unit& u, int wr, int wc, int fr, int fq) const {
        const int row0 = u.pm * 256 + wr * 64 + fr, col0 = u.pn * 256 + wc * 32 + 8 * fq;
        if (u.ks > 0) {
            float* pb = part + ((size_t)(u.ks - 1) * NSAMPLE + (row0 - NPROMPT)) * DM + col0;
#pragma unroll
            for (int ai = 0; ai < 2; ++ai)
#pragma unroll
                for (int m = 0; m < 4; ++m) { float* rowp = pb + (size_t)(ai * 128 + m * 16) * DM;
#pragma unroll
                    for (int bj = 0; bj < 2; ++bj) { *(f32x4*)(rowp + bj * 128) = acc[ai][bj][m][0]; *(f32x4*)(rowp + bj * 128 + 4) = acc[ai][bj][m][1]; } }
            return;
        }
#pragma unroll
        for (int ai = 0; ai < 2; ++ai)
#pragma unroll
            for (int m = 0; m < 4; ++m) { const size_t ro = (size_t)(row0 + ai * 128 + m * 16) * DM + col0;
#pragma unroll
                for (int bj = 0; bj < 2; ++bj) { const u32x4 xb = *(const u32x4*)(XBr + ro + bj * 128);
                    const f32x4 a0 = acc[ai][bj][m][0], a1 = acc[ai][bj][m][1]; u32x4 w;
                    w.x = cvtpk(bflo(xb.x) * ALPHA + a0[0], bfhi(xb.x) * ALPHA + a0[1]); w.y = cvtpk(bflo(xb.y) * ALPHA + a0[2], bfhi(xb.y) * ALPHA + a0[3]);
                    w.z = cvtpk(bflo(xb.z) * ALPHA + a1[0], bfhi(xb.z) * ALPHA + a1[1]); w.w = cvtpk(bflo(xb.w) * ALPHA + a1[2], bfhi(xb.w) * ALPHA + a1[3]);
                    *(u32x4*)(Zb + ro + bj * 128) = w; } }
    }
};
struct EpiUp {
    static constexpr bool PERM = true, AFTER_DRAIN = false;
    bf16_t* U;
    DI void operator()(const pg8::f32x4 (&acc)[2][2][4][2], const pg8::Unit& u, int wr, int wc, int fr, int fq) const {
        const int row0 = u.pm * 256 + wr * 64 + fr, col0 = u.pn * 256 + wc * 32 + 8 * fq;
#pragma unroll
        for (int ai = 0; ai < 2; ++ai)
#pragma unroll
            for (int m = 0; m < 4; ++m) { bf16_t* rowp = U + (size_t)(row0 + ai * 128 + m * 16) * DFF + col0;
#pragma unroll
                for (int bj = 0; bj < 2; ++bj) { f32x4 v0 = acc[ai][bj][m][0], v1 = acc[ai][bj][m][1];
#pragma unroll
                    for (int i = 0; i < 4; ++i) { float a = fmaxf(v0[i], 0.f), b = fmaxf(v1[i], 0.f); v0[i] = a * a; v1[i] = b * b; }
                    u32x4 w; w.x = cvtpk(v0[0], v0[1]); w.y = cvtpk(v0[2], v0[3]); w.z = cvtpk(v1[0], v1[1]); w.w = cvtpk(v1[2], v1[3]);
                    *(u32x4*)(rowp + bj * 128) = w; } }
    }
};
struct EpiKVQ {
    static constexpr bool PERM = false, AFTER_DRAIN = false;
    float* out; bf16_t *KB, *VB, *QB, *KS, *VS; const float* rope;
    DI void operator()(const pg8::f32x4 (&acc)[2][2][4][2], const pg8::Unit& u, int wr, int wc, int fr, int fq) const {
        const int kind = u.pn >> 2;
        const int colt = (u.pn & 3) * 256 + wc * 32 + 4 * fq;
        const bool do_rope = (kind != 1) && ((wc & 1) == 0);
#pragma unroll
        for (int ai = 0; ai < 2; ++ai)
#pragma unroll
            for (int m = 0; m < 4; ++m) {
                const int row = u.pm * 256 + wr * 64 + fr + ai * 128 + m * 16;
                const bool smp = row >= NPROMPT; const int rs = row - NPROMPT;
                const int pos = smp ? (PAST + (rs & 15)) : (row & (SEQ - 1));
                float* of; bf16_t* ob;
                if (kind == 0) { of = smp ? out + OUT_KSMP + (size_t)rs * DM : out + OUT_KP + (size_t)row * DM;
                                 ob = smp ? KS + ((size_t)(rs >> 4) * KVS_ROWS + PAST + (rs & 15)) * DM : KB + (size_t)row * DM; }
                else if (kind == 1) { of = smp ? out + OUT_VSMP + (size_t)rs * DM : out + OUT_VP + (size_t)row * DM;
                                 ob = smp ? VS + ((size_t)(rs >> 4) * KVS_ROWS + PAST + (rs & 15)) * DM : VB + (size_t)row * DM; }
                else { of = nullptr; ob = QB + (size_t)row * DM; }
#pragma unroll
                for (int bj = 0; bj < 2; ++bj)
#pragma unroll
                    for (int n = 0; n < 2; ++n) {
                        f32x4 v = acc[ai][bj][m][n];
                        if (n == 0 && do_rope) {
                            f32x4 pr; pr[0] = __shfl_xor(v[0], 32); pr[1] = __shfl_xor(v[1], 32); pr[2] = __shfl_xor(v[2], 32); pr[3] = __shfl_xor(v[3], 32);
                            const float* rp = rope + (size_t)pos * 16 + 8 * (fq & 1);
                            const f32x4 cs0 = *(const f32x4*)rp, cs1 = *(const f32x4*)(rp + 4);
                            const float sg = (fq < 2) ? -1.f : 1.f;
                            v[0] = v[0] * cs0[0] + sg * pr[0] * cs0[1]; v[1] = v[1] * cs0[2] + sg * pr[1] * cs0[3];
                            v[2] = v[2] * cs1[0] + sg * pr[2] * cs1[1]; v[3] = v[3] * cs1[2] + sg * pr[3] * cs1[3];
                        }
                        const int col = colt + bj * 128 + n * 16;
                        if (kind == 2) v = v * QSCALE_B; else *(f32x4*)(of + col) = v;
                        u32x2 w; w.x = cvtpk(v[0], v[1]); w.y = cvtpk(v[2], v[3]); *(u32x2*)(ob + col) = w;
                    }
            }
    }
};

DI float wave_sum(float v) {
#pragma unroll
    for (int o = 1; o < 64; o <<= 1) v += __shfl_xor(v, o);
    return v;
}
DI void transpose_item(const float* W, int ldw, int col0, int K, int ncols, bf16_t* WT, int row_off, float* scr, int item, int lane) {
    const int nblk = ncols / 32, kb = item / nblk, nb = item % nblk, k0 = 64 * kb, n0 = 32 * nb;
#pragma unroll 8
    for (int i = 0; i < 32; ++i) { const int kk = 2 * i + (lane >> 5); scr[kk * 33 + (lane & 31)] = W[(size_t)(k0 + kk) * ldw + col0 + n0 + (lane & 31)]; }
    asm volatile("s_waitcnt lgkmcnt(0)" ::: "memory");
    const int c = lane & 7;
#pragma unroll
    for (int j = 0; j < 4; ++j) { const int n = (lane >> 3) + 8 * j; const float* s = scr + (8 * c) * 33 + n;
        u32x4 o; o.x = cvtpk(s[0 * 33], s[1 * 33]); o.y = cvtpk(s[2 * 33], s[3 * 33]); o.z = cvtpk(s[4 * 33], s[5 * 33]); o.w = cvtpk(s[6 * 33], s[7 * 33]);
        *(u32x4*)(WT + (size_t)(row_off + n0 + n) * K + k0 + 8 * c) = o; }
    asm volatile("s_waitcnt lgkmcnt(0)" ::: "memory");
}
DI void cvt_row(const float* src, bf16_t* dstb, float* dstf, int lane) {
    const f32x4* s = (const f32x4*)src + lane;
    f32x4 v[4];
#pragma unroll
    for (int j = 0; j < 4; ++j) v[j] = s[64 * j];
    u32x2* o = (u32x2*)dstb + lane;
#pragma unroll
    for (int j = 0; j < 4; ++j) { u32x2 w; w.x = cvtpk(v[j][0], v[j][1]); w.y = cvtpk(v[j][2], v[j][3]); o[64 * j] = w; }
    if (dstf) { f32x4* f = (f32x4*)dstf + lane;
#pragma unroll
        for (int j = 0; j < 4; ++j) f[64 * j] = v[j]; }
}

DI void phase_prep(const Params& p, unsigned char* lds, int gw, int ngw, int wave, int lane) {
    unsigned char* ws = p.ws;
    float* scr = (float*)(lds + wave * 16384);
    constexpr int I_IN = 16 * 96, I_SQ = 16 * 32, I_KV = 16 * 64, I_UP = 16 * 128, I_DN = 64 * 32;
    constexpr int NIT = I_IN + I_SQ + I_KV + I_SQ + I_SQ + 2 * I_UP + 2 * I_DN;
    for (int it = gw; it < NIT; it += ngw) {
        int r = it;
        if (r < I_IN) { transpose_item(p.in[5], 3088, 0, 1024, 3072, (bf16_t*)(ws + WS_WIN), 0, scr, r, lane); continue; } r -= I_IN;
        if (r < I_SQ) { transpose_item(p.in[9], 1024, 0, 1024, 1024, (bf16_t*)(ws + WS_WOA), 0, scr, r, lane); continue; } r -= I_SQ;
        if (r < I_KV) { transpose_item(p.in[10], 2048, 0, 1024, 2048, (bf16_t*)(ws + WS_WKVQ), 0, scr, r, lane); continue; } r -= I_KV;
        if (r < I_SQ) { transpose_item(p.in[11], 1024, 0, 1024, 1024, (bf16_t*)(ws + WS_WKVQ), 2048, scr, r, lane); continue; } r -= I_SQ;
        if (r < I_SQ) { transpose_item(p.in[14], 1024, 0, 1024, 1024, (bf16_t*)(ws + WS_WOB), 0, scr, r, lane); continue; } r -= I_SQ;
        if (r < I_UP) { transpose_item(p.in[15], 4096, 0, 1024, 4096, (bf16_t*)(ws + WS_WUP0), 0, scr, r, lane); continue; } r -= I_UP;
        if (r < I_UP) { transpose_item(p.in[15] + (size_t)1024 * 4096, 4096, 0, 1024, 4096, (bf16_t*)(ws + WS_WUP1), 0, scr, r, lane); continue; } r -= I_UP;
        if (r < I_DN) { transpose_item(p.in[16], 1024, 0, 4096, 1024, (bf16_t*)(ws + WS_WDN0), 0, scr, r, lane); continue; } r -= I_DN;
        transpose_item(p.in[16] + (size_t)4096 * 1024, 1024, 0, 4096, 1024, (bf16_t*)(ws + WS_WDN1), 0, scr, r, lane);
    }
    for (int rr = gw; rr < 256; rr += ngw) {
        bf16_t* dst = (bf16_t*)(ws + WS_WIN) + (size_t)(3072 + rr) * 1024;
        for (int k = lane; k < 1024; k += 64) { const float v = (rr < 16) ? p.in[5][(size_t)k * 3088 + 3072 + rr] : 0.f; dst[k] = (bf16_t)(cvtpk(v, 0.f) & 0xffffu); }
    }
    for (int r = gw; r < NROWS; r += ngw) {
        const float* src = (r < NPROMPT) ? p.in[0] + (size_t)r * DM : p.in[1] + (size_t)(r - NPROMPT) * DM;
        cvt_row(src, (bf16_t*)(ws + WS_XB) + (size_t)r * DM, nullptr, lane);
    }
    for (int r = gw; r < 2 * 32 * KVS_ROWS; r += ngw) {
        const int which = r / (32 * KVS_ROWS), rr = r % (32 * KVS_ROWS), b = rr / KVS_ROWS, t = rr % KVS_ROWS;
        bf16_t* dst = (bf16_t*)(ws + (which ? WS_VS : WS_KS)) + (size_t)rr * DM;
        if (t < PAST) cvt_row(p.in[which ? 4 : 3] + ((size_t)b * PAST + t) * DM, dst, nullptr, lane);
        else if (t >= PAST + DEC_SEQ) { u32x4 z = {0u, 0u, 0u, 0u}; ((u32x4*)dst)[lane] = z; ((u32x4*)dst)[lane + 64] = z; }
    }
    {
        const double invrev[8] = {0.15915494309189535, 0.03086376340470123, 0.005985185712713705, 0.0011606636412400608,
                                  0.00022507907903927653, 4.364795279280289e-05, 8.464330808241401e-06, 1.6414262627950345e-06};
        float* tab = (float*)(ws + WS_ROPE);
        for (int idx = gw * 64 + lane; idx < 2048 * 8; idx += ngw * 64) {
            const int pos = idx >> 3, i = idx & 7;
            double iv = invrev[0];
#pragma unroll
            for (int q = 1; q < 8; ++q) iv = (i == q) ? invrev[q] : iv;
            const double rev = (double)pos * iv; const float fr = (float)(rev - rint(rev));
            tab[2 * idx] = __builtin_amdgcn_cosf(fr); tab[2 * idx + 1] = __builtin_amdgcn_sinf(fr);
        }
    }
}

DI void phase_ln(const bf16_t* Zb, bf16_t* XB, float* Y, const float* part, int nparts, const float* g, const float* b, bool final, int gw, int ngw, int lane) {
    f32x4 gv[4], bv[4];
#pragma unroll
    for (int j = 0; j < 4; ++j) { gv[j] = ((const f32x4*)g)[lane + 64 * j]; bv[j] = ((const f32x4*)b)[lane + 64 * j]; }
    for (int r = gw; r < NROWS; r += ngw) {
        const u32x2* zr = (const u32x2*)(Zb + (size_t)r * DM) + lane;
        f32x4 v[4]; float s = 0.f;
#pragma unroll
        for (int j = 0; j < 4; ++j) { const u32x2 z = zr[64 * j]; v[j][0] = bflo(z.x); v[j][1] = bfhi(z.x); v[j][2] = bflo(z.y); v[j][3] = bfhi(z.y); }
        if (r >= NPROMPT) {
            for (int ps = 0; ps < nparts; ++ps) { const f32x4* pr = (const f32x4*)(part + ((size_t)ps * NSAMPLE + (r - NPROMPT)) * DM) + lane;
#pragma unroll
                for (int j = 0; j < 4; ++j) v[j] = v[j] + pr[64 * j]; }
        }
#pragma unroll
        for (int j = 0; j < 4; ++j) s += (v[j][0] + v[j][1]) + (v[j][2] + v[j][3]);
        const float mean = wave_sum(s) * (1.f / DM); float s2 = 0.f;
#pragma unroll
        for (int j = 0; j < 4; ++j) { const f32x4 d = v[j] - mean; s2 += (d[0] * d[0] + d[1] * d[1]) + (d[2] * d[2] + d[3] * d[3]); }
        const float rstd = 1.f / sqrtf(wave_sum(s2) * (1.f / DM) + LN_EPS);
#pragma unroll
        for (int j = 0; j < 4; ++j) v[j] = (v[j] - mean) * rstd * gv[j] + bv[j];
        if (final) {
            f32x4* yr = (f32x4*)(Y + (size_t)r * DM) + lane;
#pragma unroll
            for (int j = 0; j < 4; ++j) yr[64 * j] = v[j];
        } else {
            u32x2* o = (u32x2*)(XB + (size_t)r * DM) + lane;
#pragma unroll
            for (int j = 0; j < 4; ++j) { u32x2 w; w.x = cvtpk(v[j][0], v[j][1]); w.y = cvtpk(v[j][2], v[j][3]); o[64 * j] = w; }
        }
    }
}

DI void phase_ognorm(bf16_t* OG, const bf16_t* H1, const float* gn, int gw, int ngw, int lane) {
    float g[16];
#pragma unroll
    for (int j = 0; j < 4; ++j) { const f32x4 t = *(const f32x4*)(gn + (16 * lane) % 256 + 4 * j); g[4 * j] = t[0]; g[4 * j + 1] = t[1]; g[4 * j + 2] = t[2]; g[4 * j + 3] = t[3]; }
    for (int r = gw; r < NROWS; r += ngw) {
        u32x4* op = (u32x4*)(OG + (size_t)r * DM + 16 * lane);
        const u32x4* rp = (const u32x4*)(H1 + (size_t)r * H1W + 2048 + 16 * lane);
        const u32x4 o0 = op[0], o1 = op[1], r0 = rp[0], r1 = rp[1];
        float o[16], rr[16];
#pragma unroll
        for (int j = 0; j < 4; ++j) { o[2 * j] = bflo(o0[j]); o[2 * j + 1] = bfhi(o0[j]); o[8 + 2 * j] = bflo(o1[j]); o[8 + 2 * j + 1] = bfhi(o1[j]);
            rr[2 * j] = bflo(r0[j]); rr[2 * j + 1] = bfhi(r0[j]); rr[8 + 2 * j] = bflo(r1[j]); rr[8 + 2 * j + 1] = bfhi(r1[j]); }
        float ss = 0.f;
#pragma unroll
        for (int j = 0; j < 16; ++j) ss += o[j] * o[j];
        ss += __shfl_xor(ss, 1); ss += __shfl_xor(ss, 2); ss += __shfl_xor(ss, 4); ss += __shfl_xor(ss, 8);
        const float rstd = 1.f / sqrtf(ss * (1.f / 256.f) + RMS_EPS);
#pragma unroll
        for (int j = 0; j < 16; ++j) { const float x = rr[j]; o[j] = o[j] * rstd * g[j] * (x / (1.f + __expf(-x))); }
        u32x4 w0, w1;
#pragma unroll
        for (int j = 0; j < 4; ++j) { w0[j] = cvtpk(o[2 * j], o[2 * j + 1]); w1[j] = cvtpk(o[8 + 2 * j], o[8 + 2 * j + 1]); }
        op[0] = w0; op[1] = w1;
    }
}

typedef __attribute__((address_space(3))) const char* LDSC;
typedef short v4i16_t __attribute__((ext_vector_type(4)));
DI s16x4 tr_read(LDSC p) { return __builtin_bit_cast(s16x4, __builtin_amdgcn_ds_read_tr16_b64_v4i16((__attribute__((address_space(3))) v4i16_t*)p)); }

DI short bf_hi(float x) { return (short)(cvtpk(x, 0.f) & 0xffffu); }
DI short bf_lo(float x) { const float hi = bflo(cvtpk(x, 0.f)); return (short)(cvtpk(x - hi, 0.f) & 0xffffu); }
template <int C>
DI void gla_pre(unsigned char* lds, bf16_t* H1, const float* GL, bf16_t* ATTg, float* DECg, size_t rbase, int chunk_id, int h, const float* Wg, const float* bg) {
    constexpr int NT = C / 16, QP = 136, EP = 132;
    const int tid = threadIdx.x, lane = tid & 63, w = __builtin_amdgcn_readfirstlane(tid >> 6), fr = lane & 15, fq = lane >> 4;
    float* EB = (float*)(lds);
    float* DECs = (float*)(lds + 33792);
    bf16_t* QF = (bf16_t*)(lds + 34816);
    bf16_t* KF = (bf16_t*)(lds + 52224);
    const int erow = tid >> 3, ec = (tid & 7) * 16; const bool eact = erow < C;
    u32x4 qr[2], kr[2];
    bf16_t* hrow = H1 + (rbase + (eact ? erow : 0)) * H1W + h * 128 + ec;
    if (eact) { qr[0] = *(const u32x4*)hrow; qr[1] = *(const u32x4*)(hrow + 8); kr[0] = *(const u32x4*)(hrow + 512); kr[1] = *(const u32x4*)(hrow + 520); }
    const int dkc = h * 128 + 16 * w + fr;
    bf16x8 b1, b2;
#pragma unroll
    for (int j = 0; j < 8; ++j) { const float wv = Wg[(8 * (fq & 1) + j) * 512 + dkc]; b1[j] = bf_hi(wv); b2[j] = (fq < 2) ? bf_lo(wv) : (short)0; }
    const float bias = bg[dkc];
    float lsv[NT][4];
#pragma unroll
    for (int ti = 0; ti < NT; ++ti) {
        const float* gp = GL + (rbase + 16 * ti + fr) * 16 + 8 * (fq & 1);
        const f32x4 g0 = *(const f32x4*)gp, g1 = *(const f32x4*)(gp + 4);
        bf16x8 a;
#pragma unroll
        for (int j = 0; j < 4; ++j) { a[j] = (fq < 2) ? bf_hi(g0[j]) : bf_lo(g0[j]); a[4 + j] = (fq < 2) ? bf_hi(g1[j]) : bf_lo(g1[j]); }
        f32x4 d = {bias, bias, bias, bias};
        d = MFMA16(a, b1, d); d = MFMA16(a, b2, d);
#pragma unroll
        for (int r = 0; r < 4; ++r) { const float lg = d[r]; lsv[ti][r] = (fminf(lg, 0.f) - __logf(1.f + __expf(-fabsf(lg)))) * (1.f / 16.f); }
    }
    float base = 0.f;
#pragma unroll
    for (int ti = 0; ti < NT; ++ti) {
        lsv[ti][1] += lsv[ti][0]; lsv[ti][2] += lsv[ti][1]; lsv[ti][3] += lsv[ti][2];
        const float tot = lsv[ti][3];
        const float t0 = __shfl(tot, fr), t1 = __shfl(tot, fr + 16), t2 = __shfl(tot, fr + 32), t3 = __shfl(tot, fr + 48);
        const float excl = ((fq > 0) ? t0 : 0.f) + ((fq > 1) ? t1 : 0.f) + ((fq > 2) ? t2 : 0.f);
#pragma unroll
        for (int r = 0; r < 4; ++r) EB[(16 * ti + 4 * fq + r) * EP + 16 * w + fr] = __expf(base + excl + lsv[ti][r]);
        base += (t0 + t1) + (t2 + t3);
    }
    const float eblast = __expf(base);
    if (fq == 0) { DECs[16 * w + fr] = eblast; DECg[((size_t)chunk_id * 4 + h) * 128 + 16 * w + fr] = eblast; }
    __syncthreads();
    if (eact) {
#pragma unroll
        for (int hh = 0; hh < 2; ++hh) {
            const f32x4 e0 = *(const f32x4*)(EB + erow * EP + ec + 8 * hh), e1 = *(const f32x4*)(EB + erow * EP + ec + 8 * hh + 4);
            const f32x4 d0 = *(const f32x4*)(DECs + ec + 8 * hh), d1 = *(const f32x4*)(DECs + ec + 8 * hh + 4);
            float eb[8] = {e0[0], e0[1], e0[2], e0[3], e1[0], e1[1], e1[2], e1[3]}, dc[8] = {d0[0], d0[1], d0[2], d0[3], d1[0], d1[1], d1[2], d1[3]};
            float qv[8], kv[8];
#pragma unroll
            for (int j = 0; j < 4; ++j) { qv[2 * j] = bflo(qr[hh][j]); qv[2 * j + 1] = bfhi(qr[hh][j]); kv[2 * j] = bflo(kr[hh][j]); kv[2 * j + 1] = bfhi(kr[hh][j]); }
            float qf[8], kf[8], kt[8];
#pragma unroll
            for (int j = 0; j < 8; ++j) { qf[j] = qv[j] * eb[j]; kf[j] = kv[j] * __builtin_amdgcn_rcpf(eb[j]); kt[j] = kf[j] * dc[j]; }
            u32x4 wq, wk, wt;
#pragma unroll
            for (int j = 0; j < 4; ++j) { wq[j] = cvtpk(qf[2 * j], qf[2 * j + 1]); wk[j] = cvtpk(kf[2 * j], kf[2 * j + 1]); wt[j] = cvtpk(kt[2 * j], kt[2 * j + 1]); }
            *(u32x4*)(QF + erow * QP + ec + 8 * hh) = wq; *(u32x4*)(KF + erow * QP + ec + 8 * hh) = wk;
            *(u32x4*)(hrow + 8 * hh) = wq; *(u32x4*)(hrow + 512 + 8 * hh) = wt;
        }
    }
    __syncthreads();
    if (C == 64 || w == 0) {
        const int ti = (C == 64) ? (w >> 1) : 0;
#pragma unroll
        for (int q = 0; q < ((C == 64) ? 2 : 1); ++q) {
            const int tj = (C == 64) ? (2 * (w & 1) + q) : 0;
            f32x4 d = {0.f, 0.f, 0.f, 0.f};
            if (tj <= ti) {
#pragma unroll
                for (int s = 0; s < 4; ++s) { const bf16x8 a = *(const bf16x8*)(QF + (16 * ti + fr) * QP + 32 * s + 8 * fq); const bf16x8 bb = *(const bf16x8*)(KF + (16 * tj + fr) * QP + 32 * s + 8 * fq); d = MFMA16(a, bb, d); }
            }
#pragma unroll
            for (int r = 0; r < 4; ++r) { const int i = 16 * ti + 4 * fq + r, j = 16 * tj + fr; ATTg[(rbase + i) * 256 + h * 64 + j] = (bf16_t)(cvtpk((j <= i) ? d[r] : 0.f, 0.f) & 0xffffu); }
        }
    }
    __syncthreads();
}

template <int C>
DI void gla_seq(unsigned char* lds, const bf16_t* H1, const bf16_t* ATTg, const float* DECg, bf16_t* OG, size_t row0, int nchunks, int chunk_id0, int h, int half,
                const float* S_init, float* S_out) {
    constexpr int CP = (C < 32) ? 32 : C, PT = CP + 8, QP = 136, NT = C / 16, NIT = (C == 64) ? 2 : 1;
    const int tid = threadIdx.x, lane = tid & 63, w = __builtin_amdgcn_readfirstlane(tid >> 6), fr = lane & 15, fq = lane >> 4;
    bf16_t* QF = (bf16_t*)(lds);
    bf16_t* KTL = (bf16_t*)(lds + 17408);
    bf16_t* VS = (bf16_t*)(lds + 34816);
    bf16_t* ATT = (bf16_t*)(lds + 52224);
    float* DEC = (float*)(lds + 61440);
    __syncthreads();
    if (C < 32) { for (int i = tid; i < 61440 / 16; i += NTHREADS) ((u32x4*)lds)[i] = (u32x4){0u, 0u, 0u, 0u}; __syncthreads(); }
    const int vcol = half * 128 + 16 * w + fr;
    f32x4 S[8];
#pragma unroll
    for (int t = 0; t < 8; ++t)
#pragma unroll
        for (int r = 0; r < 4; ++r) S[t][r] = S_init ? S_init[(size_t)(16 * t + 4 * fq + r) * 256 + vcol] : 0.f;
    const int srow = tid >> 4, sch = tid & 15;
    const bool sact = (C == 64) || (tid < 256);
    const int arow = (C == 64) ? (tid >> 3) : (tid >> 1), ach = (C == 64) ? (tid & 7) : (tid & 1);
    const bool aact = (C == 64) || (tid < 32);
    const bf16_t* hp = H1 + (row0 + srow) * H1W + sch * 8;
    const bf16_t* ap = ATTg + (row0 + arow) * 256 + h * 64 + ach * 8;
    const float* dp = DECg + ((size_t)chunk_id0 * 4 + h) * 128 + 4 * tid;
    u32x4 qreg[NIT], kreg[NIT], vreg[NIT], areg; f32x4 dreg;
#define GLA_FETCH() do { if (sact) { _Pragma("unroll") for (int it = 0; it < NIT; ++it) { const bf16_t* q_ = hp + (size_t)it * 32 * H1W; \
        qreg[it] = *(const u32x4*)(q_ + h * 128); kreg[it] = *(const u32x4*)(q_ + 512 + h * 128); vreg[it] = *(const u32x4*)(q_ + 1024 + h * 256 + half * 128); } } \
        if (aact) areg = *(const u32x4*)ap; if (tid < 32) dreg = *(const f32x4*)dp; } while (0)
    GLA_FETCH();
    const LDSC vtr0 = (LDSC)lds + 34816 + ((8 * fq + (fr >> 2)) * QP + 16 * w + 4 * (fr & 3)) * 2;
    const LDSC ktr0 = (LDSC)lds + 17408 + ((8 * fq + (fr >> 2)) * QP + 4 * (fr & 3)) * 2;
    for (int ch = 0; ch < nchunks; ++ch) {
        const size_t rbase = row0 + (size_t)ch * C;
        if (sact) {
#pragma unroll
            for (int it = 0; it < NIT; ++it) { *(u32x4*)(QF + (srow + 32 * it) * QP + sch * 8) = qreg[it]; *(u32x4*)(KTL + (srow + 32 * it) * QP + sch * 8) = kreg[it]; *(u32x4*)(VS + (srow + 32 * it) * QP + sch * 8) = vreg[it]; }
        }
        if (aact) *(u32x4*)(ATT + arow * PT + ach * 8) = areg;
        if (tid < 32) *(f32x4*)(DEC + 4 * tid) = dreg;
        __syncthreads();
        if (ch + 1 < nchunks) { hp += (size_t)C * H1W; ap += (size_t)C * 256; dp += 4 * 128; GLA_FETCH(); }
        bf16x8 vf[CP / 32];
#pragma unroll
        for (int s = 0; s < CP / 32; ++s) { const s16x4 lo = tr_read(vtr0 + (32 * s) * QP * 2), hi = tr_read(vtr0 + (32 * s + 4) * QP * 2); vf[s] = __builtin_shufflevector(lo, hi, 0, 1, 2, 3, 4, 5, 6, 7); }
        bf16x8 sf[4];
#pragma unroll
        for (int s = 0; s < 4; ++s) sf[s] = pack8(S[2 * s], S[2 * s + 1]);
#pragma unroll
        for (int ti = 0; ti < NT; ++ti) {
            f32x4 o = {0.f, 0.f, 0.f, 0.f};
#pragma unroll
            for (int s = 0; s < 4; ++s) { const s16x4 lo = *(const s16x4*)(QF + (16 * ti + fr) * QP + 32 * s + 4 * fq), hi = *(const s16x4*)(QF + (16 * ti + fr) * QP + 32 * s + 16 + 4 * fq);
                const bf16x8 a = __builtin_shufflevector(lo, hi, 0, 1, 2, 3, 4, 5, 6, 7); o = MFMA16(a, sf[s], o); }
#pragma unroll
            for (int s = 0; s < CP / 32; ++s) { const bf16x8 a = *(const bf16x8*)(ATT + (16 * ti + fr) * PT + 32 * s + 8 * fq); o = MFMA16(a, vf[s], o); }
#pragma unroll
            for (int r = 0; r < 4; ++r) OG[(rbase + 16 * ti + 4 * fq + r) * DM + h * 256 + vcol] = (bf16_t)(cvtpk(o[r], 0.f) & 0xffffu);
        }
#pragma unroll
        for (int t = 0; t < 8; ++t) {
            const f32x4 dec = *(const f32x4*)(DEC + 16 * t + 4 * fq);
            S[t] = S[t] * dec;
#pragma unroll
            for (int s = 0; s < CP / 32; ++s) { const s16x4 lo = tr_read(ktr0 + ((32 * s) * QP + 16 * t) * 2), hi = tr_read(ktr0 + ((32 * s + 4) * QP + 16 * t) * 2);
                const bf16x8 a = __builtin_shufflevector(lo, hi, 0, 1, 2, 3, 4, 5, 6, 7); S[t] = MFMA16(a, vf[s], S[t]); }
        }
        __syncthreads();
    }
#undef GLA_FETCH
#pragma unroll
    for (int t = 0; t < 8; ++t)
#pragma unroll
        for (int r = 0; r < 4; ++r) S_out[(size_t)(16 * t + 4 * fq + r) * 256 + vcol] = S[t][r];
}

typedef float f32x16 __attribute__((ext_vector_type(16)));
#define MFMA32(a, b, c) __builtin_amdgcn_mfma_f32_32x32x16_bf16((a), (b), (c), 0, 0, 0)
DI int crow32(int i, int h) { return (i & 3) + 8 * (i >> 2) + 4 * h; }
DI void attn_unit(unsigned char* lds, const bf16_t* Qp, const bf16_t* Kp, const bf16_t* Vp, bf16_t* Op, int nt_lo, int nt_hi, int kv_len, int nvalid,
                  float lam, const float* gn) {
    constexpr int KP = 136, VP = 72;
    const int tid = threadIdx.x, lane = tid & 63, w = __builtin_amdgcn_readfirstlane(tid >> 6), r = lane & 31, h = lane >> 5;
    const int qt = w & 3, map = w >> 2;
    bf16_t* KS = (bf16_t*)lds;
    bf16_t* VT = (bf16_t*)(lds + 17408);
    float* XCH = (float*)(lds + 36864);
    const bool wact = (qt * 32) < nvalid;
    const int my_nt = (qt < 2) ? nt_lo : nt_hi;
    const int qrow = qt * 32 + r;
    const LDSC vtr0 = (LDSC)lds + 17408 + ((4 * h + ((lane & 15) >> 2)) * KP + 16 * ((lane >> 4) & 1) + 4 * (lane & 3)) * 2;
    bf16x8 qf[4];
#pragma unroll
    for (int s = 0; s < 4; ++s) qf[s] = (wact && qrow < nvalid) ? *(const bf16x8*)(Qp + (size_t)qrow * DM + map * 64 + 16 * s + 8 * h) : (bf16x8){0, 0, 0, 0, 0, 0, 0, 0};
    f32x16 O[4];
#pragma unroll
    for (int n = 0; n < 4; ++n)
#pragma unroll
        for (int i = 0; i < 16; ++i) O[n][i] = 0.f;
    float mref = -INFINITY, lsum = 0.f;
    u32x4 kreg[2], vreg[2];
    const int kkey = tid >> 4, kch = tid & 15;
    const bf16_t* kptr = Kp + (size_t)kkey * DM + kch * 8;
    const bf16_t* vptr = Vp + (size_t)kkey * DM + kch * 8;
#pragma unroll
    for (int it = 0; it < 2; ++it) { kreg[it] = *(const u32x4*)(kptr + (size_t)it * 32 * DM); vreg[it] = *(const u32x4*)(vptr + (size_t)it * 32 * DM); }
    __syncthreads();
    for (int t = 0; t < nt_hi; ++t) {
#pragma unroll
        for (int it = 0; it < 2; ++it) { *(u32x4*)(KS + (kkey + 32 * it) * KP + kch * 8) = kreg[it]; *(u32x4*)(VT + (kkey + 32 * it) * KP + kch * 8) = vreg[it]; }
        __syncthreads();
        if (t + 1 < nt_hi) {
            kptr += (size_t)64 * DM; vptr += (size_t)64 * DM;
#pragma unroll
            for (int it = 0; it < 2; ++it) { kreg[it] = *(const u32x4*)(kptr + (size_t)it * 32 * DM); vreg[it] = *(const u32x4*)(vptr + (size_t)it * 32 * DM); }
        }
        if (wact && t < my_nt) {
            f32x16 Sx[2];
#pragma unroll
            for (int kt = 0; kt < 2; ++kt) {
                f32x16 a;
#pragma unroll
                for (int i = 0; i < 16; ++i) a[i] = 0.f;
#pragma unroll
                for (int s = 0; s < 4; ++s) { const bf16x8 kf = *(const bf16x8*)(KS + (32 * kt + r) * KP + map * 64 + 16 * s + 8 * h); a = MFMA32(kf, qf[s], a); }
                Sx[kt] = a;
            }
            const int key0 = t * 64;
            if (key0 + 64 > kv_len) {
#pragma unroll
                for (int kt = 0; kt < 2; ++kt)
#pragma unroll
                    for (int i = 0; i < 16; ++i) if (key0 + 32 * kt + crow32(i, h) >= kv_len) Sx[kt][i] = -INFINITY;
            }
            float mx = -INFINITY;
#pragma unroll
            for (int kt = 0; kt < 2; ++kt)
#pragma unroll
                for (int i = 0; i < 16; ++i) mx = fmaxf(mx, Sx[kt][i]);
            mx = fmaxf(mx, __shfl_xor(mx, 32));
            if (__any(mx > mref + 8.f)) {
                const float mnew = fmaxf(mref, mx); const float corr = __builtin_amdgcn_exp2f(mref - mnew); mref = mnew; lsum *= corr;
#pragma unroll
                for (int n = 0; n < 4; ++n) O[n] = O[n] * corr;
            }
            float ps = 0.f;
#pragma unroll
            for (int kt = 0; kt < 2; ++kt)
#pragma unroll
                for (int i = 0; i < 16; ++i) { const float pv = __builtin_amdgcn_exp2f(Sx[kt][i] - mref); Sx[kt][i] = pv; ps += pv; }
            lsum += ps;
            bf16x8 pf[4];
#pragma unroll
            for (int sp = 0; sp < 4; ++sp) { const int kt = sp >> 1, b8 = 8 * (sp & 1); u32x4 pk;
                pk.x = cvtpk(Sx[kt][b8], Sx[kt][b8 + 1]); pk.y = cvtpk(Sx[kt][b8 + 2], Sx[kt][b8 + 3]); pk.z = cvtpk(Sx[kt][b8 + 4], Sx[kt][b8 + 5]); pk.w = cvtpk(Sx[kt][b8 + 6], Sx[kt][b8 + 7]);
                pf[sp] = __builtin_bit_cast(bf16x8, pk); }
#pragma unroll
            for (int n = 0; n < 4; ++n)
#pragma unroll
                for (int sp = 0; sp < 4; ++sp) {
                    const s16x4 lo = tr_read(vtr0 + ((16 * sp) * KP + 32 * n) * 2), hi = tr_read(vtr0 + ((16 * sp + 8) * KP + 32 * n) * 2);
                    const bf16x8 vf = __builtin_shufflevector(lo, hi, 0, 1, 2, 3, 4, 5, 6, 7);
                    O[n] = MFMA32(vf, pf[sp], O[n]);
                }
        }
        __syncthreads();
    }
    lsum += __shfl_xor(lsum, 32);
    if (map == 1 && wact) {
        const float sc = lam / lsum;
#pragma unroll
        for (int n = 0; n < 4; ++n)
#pragma unroll
            for (int g = 0; g < 4; ++g) { f32x4 v; v[0] = O[n][4 * g] * sc; v[1] = O[n][4 * g + 1] * sc; v[2] = O[n][4 * g + 2] * sc; v[3] = O[n][4 * g + 3] * sc;
                *(f32x4*)(XCH + (size_t)((qt * 16 + n * 4 + g) * 64 + lane) * 4) = v; }
    }
    __syncthreads();
    if (map == 0 && wact) {
        const float inv = 1.f / lsum; float ss = 0.f;
#pragma unroll
        for (int n = 0; n < 4; ++n)
#pragma unroll
            for (int g = 0; g < 4; ++g) { const f32x4 x = *(const f32x4*)(XCH + (size_t)((qt * 16 + n * 4 + g) * 64 + lane) * 4);
#pragma unroll
                for (int j = 0; j < 4; ++j) { const float o = O[n][4 * g + j] * inv - x[j]; O[n][4 * g + j] = o; ss += o * o; } }
        ss += __shfl_xor(ss, 32);
        const float rstd = (1.f - LAMBDA_INIT) / sqrtf(ss * (1.f / 128.f) + RMS_EPS);
        if (qrow < nvalid) {
#pragma unroll
            for (int n = 0; n < 4; ++n)
#pragma unroll
                for (int g = 0; g < 4; ++g) { const int dv0 = 32 * n + 8 * g + 4 * h; const f32x4 gv = *(const f32x4*)(gn + dv0);
                    u32x2 wv; wv.x = cvtpk(O[n][4 * g] * gv[0] * rstd, O[n][4 * g + 1] * gv[1] * rstd); wv.y = cvtpk(O[n][4 * g + 2] * gv[2] * rstd, O[n][4 * g + 3] * gv[3] * rstd);
                    *(u32x2*)(Op + (size_t)qrow * DM + dv0) = wv; }
        }
    }
}

#define LAS __attribute__((address_space(3)))
#define XB_TMO      128
#define XB_XCNT(j)  (256  + 64 * (j))
#define XB_XSUB(j)  (1280 + 64 * (j))
#define XB_XGEN(j)  (2304 + 64 * (j))
#define XB_TOP      3328
#define XB_TOPGEN   3392
#define XCD_BAR_WORDS 3456
#define XB_SPIN_CAP (1u << 18)

__device__ __forceinline__ unsigned xb_ld(unsigned* p)              { return __hip_atomic_load(p, __ATOMIC_RELAXED, __HIP_MEMORY_SCOPE_AGENT); }
__device__ __forceinline__ unsigned xb_add(unsigned* p, unsigned v) { return __hip_atomic_fetch_add(p, v, __ATOMIC_RELAXED, __HIP_MEMORY_SCOPE_AGENT); }
__device__ __forceinline__ unsigned xb_xcc_id() { return (unsigned)__builtin_amdgcn_s_getreg((3 << 11) | 20) & 0xFu; }
#define XB_SPIN(cond, bar) do { unsigned _sp = 0; while (cond) { __builtin_amdgcn_s_sleep(1); \
    if ((++_sp & 255u) == 0u) { if (xb_ld(&(bar)[XB_TMO])) break; if (_sp > XB_SPIN_CAP) { atomicAdd(&(bar)[XB_TMO], 1u); break; } } } } while (0)

struct XcdBarrier {
    unsigned* bar; unsigned x;
    volatile LAS unsigned* st;
};

__device__ __forceinline__ XcdBarrier xcd_barrier_post(unsigned* bar, volatile LAS unsigned* st) {
    XcdBarrier b; b.bar = bar; b.x = xb_xcc_id(); b.st = st;
    if (threadIdx.x == 0) (void)xb_add(&bar[XB_XCNT(b.x)], 1u);
    return b;
}
__device__ __forceinline__ void xcd_barrier_complete(unsigned* bar, unsigned x, unsigned& nloc, unsigned& nx) {
    const unsigned G = gridDim.x * gridDim.y * gridDim.z;
    unsigned sum, cnt, mine, sp = 0u;
    for (;;) {
        sum = 0u; cnt = 0u; mine = 0u;
#pragma unroll
        for (unsigned j = 0; j < 16; ++j) { const unsigned c = xb_ld(&bar[XB_XCNT(j)]); sum += c; cnt += (c > 0u) ? 1u : 0u; mine = (j == x) ? c : mine; }
        if (sum == G) break;
        __builtin_amdgcn_s_sleep(1);
        if ((++sp & 255u) == 0u) { if (xb_ld(&bar[XB_TMO])) break; if (sp > XB_SPIN_CAP) { atomicAdd(&bar[XB_TMO], 1u); break; } }
    }
    nloc = mine > 0u ? mine : 1u; nx = cnt > 0u ? cnt : 1u;
}

__device__ __forceinline__ void xcd_barrier(const XcdBarrier& b) {
    asm volatile("s_waitcnt vmcnt(0)" ::: "memory");
    __syncthreads();
    if (threadIdx.x == 0) {
        unsigned* bar = b.bar;
        __builtin_amdgcn_s_waitcnt(0);
        unsigned nloc = b.st[0], nx = b.st[1];
        if (nloc == 0u) { xcd_barrier_complete(bar, b.x, nloc, nx); b.st[0] = nloc; b.st[1] = nx; }
        const unsigned old = xb_add(&bar[XB_XSUB(b.x)], 1u);
        const unsigned gen = old / nloc;
        if (old + 1u == (gen + 1u) * nloc) {
            __builtin_amdgcn_fence(__ATOMIC_RELEASE, "agent");
            asm volatile("s_waitcnt vmcnt(0)" ::: "memory");
            const unsigned og = xb_add(&bar[XB_TOP], 1u);
            const unsigned tg = og / nx;
            if (og + 1u == (tg + 1u) * nx) xb_add(&bar[XB_TOPGEN], 1u);
            else XB_SPIN(xb_ld(&bar[XB_TOPGEN]) == tg, bar);
            __builtin_amdgcn_fence(__ATOMIC_ACQUIRE, "agent");
            xb_add(&bar[XB_XGEN(b.x)], 1u);
            asm volatile("s_waitcnt vmcnt(0)" ::: "memory");
        } else {
            XB_SPIN(xb_ld(&bar[XB_XGEN(b.x)]) == gen, bar);
            __builtin_amdgcn_fence(__ATOMIC_ACQUIRE, "agent");
            asm volatile("s_waitcnt vmcnt(0)" ::: "memory");
        }
    }
    __syncthreads();
}

constexpr int NPHASE = 16;
__global__ void __launch_bounds__(NTHREADS) yoco_fwd(Params p) {
    extern __shared__ __attribute__((aligned(16))) unsigned char lds[];
    cg::grid_group grid = cg::this_grid();
    const int tid = threadIdx.x, lane = tid & 63, wave = __builtin_amdgcn_readfirstlane(tid >> 6);
    const int G = gridDim.x, bx = blockIdx.x;
    const int gw = bx * NWAVES + wave, ngw = G * NWAVES;
    unsigned char* ws = p.ws;
    bf16_t* XB = (bf16_t*)(ws + WS_XB);
    float* XR = p.out;
    float* GL = (float*)(ws + WS_GL);
    bf16_t* ZB = (bf16_t*)(ws + WS_ZB);
    bf16_t* ATTg = (bf16_t*)(ws + WS_ATTG);
    float* DECg = (float*)(ws + WS_DECG);
    float* PART = (float*)(ws + WS_PART);
    bf16_t* H1 = (bf16_t*)(ws + WS_BIG + BIG_H1);
    bf16_t* OG = (bf16_t*)(ws + WS_BIG + BIG_OG);
    bf16_t* U = (bf16_t*)(ws + WS_BIG + BIG_U);
    bf16_t* KB = (bf16_t*)(ws + WS_BIG + BIG_KB);
    bf16_t* VB = (bf16_t*)(ws + WS_BIG + BIG_VB);
    bf16_t* QB = (bf16_t*)(ws + WS_BIG + BIG_QB);
    bf16_t* OB = (bf16_t*)(ws + WS_BIG + BIG_OB);
    bf16_t* KSb = (bf16_t*)(ws + WS_KS);
    bf16_t* VSb = (bf16_t*)(ws + WS_VS);
    if (tid < 2) ((volatile LAS unsigned*)((LAS unsigned char*)lds + (LDS_BYTES - 16)))[tid] = 0u;
    __syncthreads();
    XcdBarrier xbar = xcd_barrier_post((unsigned*)(ws + WS_CTL), (volatile LAS unsigned*)((LAS unsigned char*)lds + (LDS_BYTES - 16)));
    const int lo = p.ph_lo, hi = p.ph_hi;
#define IN(k) (lo <= (k) && (k) < hi)
#define SEAM(k) do { if (IN(k) && IN((k) + 1)) { if ((k) == 0) grid.sync(); else xcd_barrier(xbar); } } while (0)
#define LDSP ((PG8_LAS unsigned char*)lds)
#ifndef PROBE_DUP
#define PROBE_DUP -1
#endif
#define REPS(k) ((PROBE_DUP == (k)) ? 2 : 1)
#define PH(k) if (IN(k)) for (int rep_ = 0; rep_ < REPS(k); ++rep_, (rep_ < REPS(k) ? grid.sync() : (void)0))

    PH(0) { phase_prep(p, lds, gw, ngw, wave, lane); }
    SEAM(0);
    PH(1) { pg8::Gemm g{XB, (const bf16_t*)(ws + WS_WIN), NROWS, NWIN, 1024}; pg8::MixOrder S; S.init(NWIN, 1024, 1, G, bx); EpiH1 E{H1, GL};
        pg8::gemm_phase<EpiH1, pg8::MixOrder, true, true>(LDSP, g, S, E); }
    SEAM(1);
    PH(2) {
        for (int u = bx; u < 4096 + 128; u += G) {
            if (u < 4096) { const int h = u & 3, cid = u >> 2; gla_pre<64>(lds, H1, GL, ATTg, DECg, (size_t)cid * 64, cid, h, p.in[6], p.in[7]); }
            else { const int v = u - 4096, h = v & 3, b = v >> 2; gla_pre<16>(lds, H1, GL, ATTg, DECg, (size_t)NPROMPT + (size_t)b * DEC_SEQ, 1024 + b, h, p.in[6], p.in[7]); }
        }
        xcd_barrier(xbar);
        for (int u = bx; u < 512; u += G) {
            if (u < 256) { const int b = u >> 3, h = (u >> 1) & 3, half = u & 1;
                gla_seq<64>(lds, H1, ATTg, DECg, OG, (size_t)b * SEQ, SEQ / 64, b * 32, h, half, nullptr, p.out + OUT_SP + (size_t)(b * 4 + h) * 128 * 256); }
            else { const int v = u - 256, b = v >> 3, h = (v >> 1) & 3, half = v & 1;
                gla_seq<16>(lds, H1, ATTg, DECg, OG, (size_t)NPROMPT + (size_t)b * DEC_SEQ, 1, 1024 + b, h, half, p.in[2] + (size_t)(b * 4 + h) * 128 * 256, p.out + OUT_SS + (size_t)(b * 4 + h) * 128 * 256); }
        }
    }
    SEAM(2);
    PH(3) { phase_ognorm(OG, H1, p.in[8], gw, ngw, lane); }
    SEAM(3);
    PH(4) { pg8::Gemm g{OG, (const bf16_t*)(ws + WS_WOA), NROWS, 1024, 1024}; pg8::MixOrder S; S.init(1024, 1024, 4, G, bx); EpiRes E{ZB, XB, PART};
        pg8::gemm_phase<EpiRes, pg8::MixOrder, true, true>(LDSP, g, S, E); }
    SEAM(4);
    PH(5) { phase_ln(ZB, XB, nullptr, PART, 3, p.in[17], p.in[18], false, gw, ngw, lane); }
    SEAM(5);
    PH(6) { pg8::Gemm g{XB, (const bf16_t*)(ws + WS_WUP0), NROWS, DFF, 1024}; pg8::MixOrder S; S.init(DFF, 1024, 1, G, bx); EpiUp E{U};
        pg8::gemm_phase<EpiUp, pg8::MixOrder, true, true>(LDSP, g, S, E); }
    SEAM(6);
    PH(7) { pg8::Gemm g{U, (const bf16_t*)(ws + WS_WDN0), NROWS, 1024, DFF}; pg8::MixOrder S; S.init(1024, DFF, 16, G, bx); EpiRes E{ZB, XB, PART};
        pg8::gemm_phase<EpiRes, pg8::MixOrder, true, true>(LDSP, g, S, E); }
    SEAM(7);
    PH(8) { phase_ln(ZB, XB, nullptr, PART, 15, p.in[17] + 1024, p.in[18] + 1024, false, gw, ngw, lane); }
    SEAM(8);
    PH(9) { pg8::Gemm g{XB, (const bf16_t*)(ws + WS_WKVQ), NROWS, 3072, 1024}; pg8::MixOrder S; S.init(3072, 1024, 1, G, bx);
        EpiKVQ E{p.out, KB, VB, QB, KSb, VSb, (const float*)(ws + WS_ROPE)};
        pg8::gemm_phase<EpiKVQ, pg8::MixOrder, true, true>(LDSP, g, S, E); }
    SEAM(9);
    PH(10) {
        const float* lm = p.in[12];
        const float d1 = wave_sum(lm[lane] * lm[64 + lane]), d2 = wave_sum(lm[128 + lane] * lm[192 + lane]);
        const float lam = __expf(d1) - __expf(d2) + LAMBDA_INIT;
        if (G == 256) {
            const int vcu = (bx & 7) * 32 + (bx >> 3), xcd = vcu >> 5, local = vcu & 31, sub = local >> 3, sx = local & 7;
            for (int rd = 0; rd < 8; ++rd) {
                const int u = xcd * 32 + rd * 4 + sub, b = u >> 3, h = u & 7;
                for (int q = 0; q < 2; ++q) {
                    const int i = q ? sx : 15 - sx;
                    const size_t qrow = (size_t)b * SEQ + 128 * i;
                    attn_unit(lds, QB + qrow * DM + h * 128, KB + (size_t)b * SEQ * DM + h * 128, VB + (size_t)b * SEQ * DM + h * 128, OB + qrow * DM + h * 128,
                              2 * i + 1, 2 * i + 2, 1 << 30, 128, lam, p.in[13]);
                }
            }
        } else {
            for (int u = bx; u < 256; u += G) {
                const int b = u >> 3, h = u & 7;
                for (int i = 15; i >= 0; --i) {
                    const size_t qrow = (size_t)b * SEQ + 128 * i;
                    attn_unit(lds, QB + qrow * DM + h * 128, KB + (size_t)b * SEQ * DM + h * 128, VB + (size_t)b * SEQ * DM + h * 128, OB + qrow * DM + h * 128,
                              2 * i + 1, 2 * i + 2, 1 << 30, 128, lam, p.in[13]);
                }
            }
        }
        for (int u = bx; u < 256; u += G) {
            const int b = u >> 3, h = u & 7;
            const size_t qrow = (size_t)NPROMPT + (size_t)b * DEC_SEQ;
            attn_unit(lds, QB + qrow * DM + h * 128, KSb + (size_t)b * KVS_ROWS * DM + h * 128, VSb + (size_t)b * KVS_ROWS * DM + h * 128, OB + qrow * DM + h * 128,
                      17, 17, PAST + DEC_SEQ, DEC_SEQ, lam, p.in[13]);
        }
    }
    SEAM(10);
    PH(11) { pg8::Gemm g{OB, (const bf16_t*)(ws + WS_WOB), NROWS, 1024, 1024}; pg8::MixOrder S; S.init(1024, 1024, 4, G, bx); EpiRes E{ZB, XB, PART};
        pg8::gemm_phase<EpiRes, pg8::MixOrder, true, true>(LDSP, g, S, E); }
    SEAM(11);
    PH(12) { phase_ln(ZB, XB, nullptr, PART, 3, p.in[17] + 2048, p.in[18] + 2048, false, gw, ngw, lane); }
    SEAM(12);
    PH(13) { pg8::Gemm g{XB, (const bf16_t*)(ws + WS_WUP1), NROWS, DFF, 1024}; pg8::MixOrder S; S.init(DFF, 1024, 1, G, bx); EpiUp E{U};
        pg8::gemm_phase<EpiUp, pg8::MixOrder, true, true>(LDSP, g, S, E); }
    SEAM(13);
    PH(14) { pg8::Gemm g{U, (const bf16_t*)(ws + WS_WDN1), NROWS, 1024, DFF}; pg8::MixOrder S; S.init(1024, DFF, 16, G, bx); EpiRes E{ZB, XB, PART};
        pg8::gemm_phase<EpiRes, pg8::MixOrder, true, true>(LDSP, g, S, E); }
    SEAM(14);
    PH(15) { phase_ln(ZB, nullptr, p.out, PART, 15, p.in[17] + 3072, p.in[18] + 3072, true, gw, ngw, lane); }
#undef IN
#undef SEAM
}

#ifndef ONE_LAUNCH
#define ONE_LAUNCH 1
#endif
extern "C" void kernel_launch(void* const* d_in, const int* in_sizes, int n_in, void* d_out, int out_size, void* d_ws, size_t ws_size, hipStream_t stream) {
    static int grid = 0;
    if (grid == 0) {
        if (n_in != 19 || ws_size < WS_END) { fprintf(stderr, "kernel_launch: unexpected n_in %d / ws_size %zu (need %zu)\n", n_in, ws_size, (size_t)WS_END); grid = -1; return; }
        int dev = 0, cus = 0, per_cu = 0;
        hipGetDevice(&dev); hipDeviceGetAttribute(&cus, hipDeviceAttributeMultiprocessorCount, dev);
        if (hipFuncSetAttribute((const void*)yoco_fwd, hipFuncAttributeMaxDynamicSharedMemorySize, LDS_BYTES) != hipSuccess) { fprintf(stderr, "kernel_launch: hipFuncSetAttribute failed\n"); grid = -1; return; }
        if (hipOccupancyMaxActiveBlocksPerMultiprocessor(&per_cu, (const void*)yoco_fwd, NTHREADS, LDS_BYTES) != hipSuccess || per_cu < 1) { fprintf(stderr, "kernel_launch: occupancy query says %d\n", per_cu); per_cu = 1; }
        (void)hipGetLastError();
        grid = cus * 1;
        if (grid <= 0) grid = 256;
    }
    if (grid < 0) return;
    Params p{};
    for (int i = 0; i < 19; ++i) p.in[i] = (const float*)d_in[i];
    p.out = (float*)d_out; p.ws = (unsigned char*)d_ws;
#if ONE_LAUNCH
    if (hipMemsetAsync((char*)d_ws + WS_CTL, 0, CTL_BYTES, stream) != hipSuccess) { fprintf(stderr, "kernel_launch: memset of barrier words failed\n"); return; }
    p.ph_lo = 0; p.ph_hi = NPHASE;
    void* args[] = {&p};
    hipError_t e = hipLaunchCooperativeKernel((const void*)yoco_fwd, dim3(grid), dim3(NTHREADS), args, LDS_BYTES, stream);
    if (e != hipSuccess) fprintf(stderr, "cooperative launch failed: %s (grid %d)\n", hipGetErrorString(e), grid);
#else
    for (int ph = 0; ph < NPHASE; ++ph) {
        p.ph_lo = ph; p.ph_hi = ph + 1;
        hipLaunchKernelGGL(yoco_fwd, dim3(grid), dim3(NTHREADS), LDS_BYTES, stream, p);
    }
#endif
}
```
